# Optimizing an MI355X kernel written in HIP

```python
import jax, jax.numpy as jnp
from jax import lax
import numpy as np

D_MODEL = 1024
BATCH = 2
SEQ = 8192
DEPTH = 2

HEAD_DIM = 64
N_Q_HEADS = 8
N_KV_HEADS = 2
ATTN_WIDTH = N_Q_HEADS * HEAD_DIM
KV_WIDTH = N_KV_HEADS * HEAD_DIM
LRU_HEADS = 4
LRU_WIDTH = LRU_HEADS * HEAD_DIM
CONV_GROUPS = 4
CONV_WIDTH = CONV_GROUPS * HEAD_DIM
MIX_WIDTH = ATTN_WIDTH + LRU_WIDTH + CONV_WIDTH
IN_SPLITS = (ATTN_WIDTH, KV_WIDTH, KV_WIDTH, LRU_WIDTH, LRU_WIDTH, CONV_WIDTH, CONV_WIDTH, CONV_WIDTH)
IN_PROJ_WIDTH = sum(IN_SPLITS)
WINDOW = 128
BLOCK = 128
LRU_CONV_K = 4
SHORT_CONV_K = 3
LRU_C = 8.0
D_FF = ((8 * D_MODEL // 3 + 127) // 128) * 128
N_SUBLAYERS = 3
N_MOD = 3 * N_SUBLAYERS
EPS = 1e-6
NEG_INF = -1e30

kernel_name = "hymba_hybrid_rglru_swa_shortconv_macaron"


def rmsnorm(x, g):
    xf = x.astype(jnp.float32)
    y = xf * lax.rsqrt(jnp.mean(xf * xf, axis=-1, keepdims=True) + EPS)
    return (y * g.astype(jnp.float32)).astype(x.dtype)


def modulate(x, g, shift, scale):
    return rmsnorm(x, g) * (1.0 + scale[:, None, :]) + shift[:, None, :]


def swiglu(h, w_gu, w_down):
    gu = h @ w_gu
    g, u = jnp.split(gu, 2, axis=-1)
    return (jax.nn.silu(g) * u) @ w_down


def causal_depthwise_conv(x, w, b=None):
    K = w.shape[0]
    S = x.shape[1]
    xp = jnp.pad(x, ((0, 0), (K - 1, 0), (0, 0)))
    y = xp[:, 0:S] * w[0]
    for k in range(1, K):
        y = y + xp[:, k:k + S] * w[k]
    if b is not None:
        y = y + b
    return y


def alibi_slopes(n_heads):
    return jnp.asarray(2.0 ** (-8.0 * np.arange(1, n_heads + 1) / n_heads), dtype=jnp.float32)


def sliding_window_attention(q, k, v, sinks):
    b, s = q.shape[:2]
    nb = s // BLOCK
    G = N_Q_HEADS // N_KV_HEADS
    qb = q.reshape(b, nb, BLOCK, N_KV_HEADS, G, HEAD_DIM)

    def band(t):
        tb = t.reshape(b, nb, BLOCK, N_KV_HEADS, HEAD_DIM)
        prev = jnp.pad(tb[:, :-1], ((0, 0), (1, 0), (0, 0), (0, 0), (0, 0)))
        return jnp.concatenate([prev, tb], axis=2)

    kb, vb = band(k), band(v)
    scores = jnp.einsum('bnqkgd,bnskd->bnkgqs', qb, kb).astype(jnp.float32) * (HEAD_DIM ** -0.5)
    qi = jnp.arange(BLOCK)[:, None]
    kj = jnp.arange(2 * BLOCK)[None, :]
    dist = qi + BLOCK - kj
    in_window = (dist >= 0) & (dist < WINDOW)
    blk = jnp.arange(nb)[:, None, None]
    valid = in_window[None] & ((blk > 0) | (kj[None] >= BLOCK))
    slopes = alibi_slopes(N_Q_HEADS).reshape(N_KV_HEADS, G)
    bias = -slopes[:, :, None, None] * dist.astype(jnp.float32)
    scores = jnp.where(valid[None, :, None, None], scores + bias[None, None], NEG_INF)
    sink = sinks.astype(jnp.float32).reshape(N_KV_HEADS, G)[None, None, :, :, None, None]
    m = jnp.maximum(jnp.max(scores, axis=-1, keepdims=True), sink)
    p = jnp.exp(scores - m)
    denom = jnp.sum(p, axis=-1, keepdims=True) + jnp.exp(sink - m)
    out = jnp.einsum('bnkgqs,bnskd->bnqkgd', (p / denom).astype(v.dtype), vb)
    return out.reshape(b, s, ATTN_WIDTH)


def rg_lru(x, gate_a_w, gate_a_b, gate_x_w, gate_x_b, lam):
    b, s, _ = x.shape
    xh = x.reshape(b, s, LRU_HEADS, HEAD_DIM)
    r = jax.nn.sigmoid(jnp.einsum('bshd,hde->bshe', xh, gate_a_w).reshape(b, s, LRU_WIDTH) + gate_a_b)
    i = jax.nn.sigmoid(jnp.einsum('bshd,hde->bshe', xh, gate_x_w).reshape(b, s, LRU_WIDTH) + gate_x_b)
    log_a = -LRU_C * r.astype(jnp.float32) * jax.nn.softplus(-lam.astype(jnp.float32))
    a = jnp.exp(log_a)
    mult = jnp.sqrt(-jnp.expm1(2.0 * log_a))
    first = (jnp.arange(s) == 0)[None, :, None]
    mult = jnp.where(first, 1.0, mult)
    u = mult * (i * x).astype(jnp.float32)

    def combine(left, right):
        a1, b1 = left
        a2, b2 = right
        return a1 * a2, a2 * b1 + b2

    _, h = lax.associative_scan(combine, (a, u), axis=1)
    return h.astype(x.dtype)


def hybrid_mixer(h, w_in, w_out, sinks, lru_conv_w, lru_conv_b, lru_gate_a_w, lru_gate_a_b,
                 lru_gate_x_w, lru_gate_x_b, lru_lambda, sc_conv_w):
    proj = h @ w_in
    offs = np.cumsum(IN_SPLITS)[:-1].tolist()
    q, k, v, lx, lg, sb, sc, sx = jnp.split(proj, offs, axis=-1)
    y_attn = sliding_window_attention(q, k, v, sinks)
    lx = causal_depthwise_conv(lx, lru_conv_w, lru_conv_b)
    y_lru = jax.nn.gelu(lg) * rg_lru(lx, lru_gate_a_w, lru_gate_a_b, lru_gate_x_w, lru_gate_x_b, lru_lambda)
    y_sc = sb * causal_depthwise_conv(sc * sx, sc_conv_w)
    y = jnp.concatenate([y_attn, y_lru, y_sc], axis=-1)
    return y @ w_out


def setup_inputs(seed: int = 0) -> dict:
    key = jax.random.key(seed)
    ks = jax.random.split(key, 24)
    f32 = jnp.float32

    def nrm(k, shape, scale):
        return jax.random.normal(k, shape, f32) * scale

    u = jax.random.uniform(ks[17], (DEPTH, LRU_WIDTH), f32, 0.9, 0.999)
    a0 = u ** (1.0 / LRU_C)
    lru_lambda = jnp.log(a0) - jnp.log1p(-a0)
    return {
        "x": nrm(ks[0], (BATCH, SEQ, D_MODEL), 1.0),
        "c": nrm(ks[1], (BATCH, D_MODEL), 1.0),
        "w_mod": nrm(ks[2], (DEPTH, D_MODEL, N_MOD * D_MODEL), D_MODEL ** -0.5),
        "b_mod": nrm(ks[3], (DEPTH, N_MOD * D_MODEL), 0.02),
        "g_norm": 1.0 + nrm(ks[4], (DEPTH, N_SUBLAYERS, D_MODEL), 0.02),
        "w_ffn1_gu": nrm(ks[5], (DEPTH, D_MODEL, 2 * D_FF), D_MODEL ** -0.5),
        "w_ffn1_down": nrm(ks[6], (DEPTH, D_FF, D_MODEL), D_FF ** -0.5),
        "w_ffn2_gu": nrm(ks[7], (DEPTH, D_MODEL, 2 * D_FF), D_MODEL ** -0.5),
        "w_ffn2_down": nrm(ks[8], (DEPTH, D_FF, D_MODEL), D_FF ** -0.5),
        "w_in": nrm(ks[9], (DEPTH, D_MODEL, IN_PROJ_WIDTH), D_MODEL ** -0.5),
        "w_out": nrm(ks[10], (DEPTH, MIX_WIDTH, D_MODEL), MIX_WIDTH ** -0.5),
        "attn_sinks": nrm(ks[11], (DEPTH, N_Q_HEADS), 0.5),
        "lru_conv_w": nrm(ks[12], (DEPTH, LRU_CONV_K, LRU_WIDTH), LRU_CONV_K ** -0.5),
        "lru_conv_b": nrm(ks[13], (DEPTH, LRU_WIDTH), 0.02),
        "lru_gate_a_w": nrm(ks[14], (DEPTH, LRU_HEADS, HEAD_DIM, HEAD_DIM), HEAD_DIM ** -0.5),
        "lru_gate_a_b": nrm(ks[15], (DEPTH, LRU_WIDTH), 0.02),
        "lru_gate_x_w": nrm(ks[16], (DEPTH, LRU_HEADS, HEAD_DIM, HEAD_DIM), HEAD_DIM ** -0.5),
        "lru_gate_x_b": nrm(ks[18], (DEPTH, LRU_WIDTH), 0.02),
        "lru_lambda": lru_lambda,
        "sc_conv_w": nrm(ks[19], (DEPTH, SHORT_CONV_K, CONV_WIDTH), SHORT_CONV_K ** -0.5),
        "g_final": 1.0 + nrm(ks[20], (D_MODEL,), 0.02),
    }


def reference(x, c, w_mod, b_mod, g_norm, w_ffn1_gu, w_ffn1_down, w_ffn2_gu, w_ffn2_down,
              w_in, w_out, attn_sinks, lru_conv_w, lru_conv_b, lru_gate_a_w, lru_gate_a_b,
              lru_gate_x_w, lru_gate_x_b, lru_lambda, sc_conv_w, g_final):
    c_act = jax.nn.silu(c)
    for l in range(DEPTH):
        mod = (c_act @ w_mod[l] + b_mod[l]).reshape(c.shape[0], N_MOD, D_MODEL)
        h = modulate(x, g_norm[l, 0], mod[:, 0], mod[:, 1])
        x = x + 0.5 * mod[:, 2][:, None, :] * swiglu(h, w_ffn1_gu[l], w_ffn1_down[l])
        h = modulate(x, g_norm[l, 1], mod[:, 3], mod[:, 4])
        x = x + mod[:, 5][:, None, :] * hybrid_mixer(
            h, w_in[l], w_out[l], attn_sinks[l], lru_conv_w[l], lru_conv_b[l],
            lru_gate_a_w[l], lru_gate_a_b[l], lru_gate_x_w[l], lru_gate_x_b[l],
            lru_lambda[l], sc_conv_w[l])
        h = modulate(x, g_norm[l, 2], mod[:, 6], mod[:, 7])
        x = x + 0.5 * mod[:, 8][:, None, :] * swiglu(h, w_ffn2_gu[l], w_ffn2_down[l])
    return rmsnorm(x, g_final)
```

```cpp
#include <hip/hip_runtime.h>
#include <hip/hip_bf16.h>
#include <cstdio>
#include <cstdint>
#include <cmath>
namespace pg8 {
#define PG8_LAS __attribute__((address_space(3)))
typedef unsigned short bf16_t;
typedef short bf16x8 __attribute__((ext_vector_type(8)));
typedef float f32x4 __attribute__((ext_vector_type(4)));
typedef unsigned u32x4 __attribute__((ext_vector_type(4)));
constexpr int BM = 256, BK = 64, HALF = 128, HTB = HALF * BK * 2  , STAGE_BYTES = 8 * HTB, NXCD = 8, WGM = 8;

__host__ __device__ __forceinline__ int lds_byte(int r, int c) { const int st = (r >> 4) * 2 + (c >> 5), rr = r & 15, cc = c & 31, ob = rr * 64 + cc * 2; return st * 1024 + (ob ^ (((ob >> 9) & 1) << 5)); }
__host__ __device__ __forceinline__ void stage_rc(int b, int& R, int& C) { const int st = b / 1024, sb = b % 1024, swz = sb ^ (((sb >> 9) & 1) << 5); R = (st >> 1) * 16 + swz / 64; C = (st & 1) * 32 + (swz % 64) / 2; }
__host__ __device__ __forceinline__ int perm32(int rho) { const int n = rho >> 4, i = rho & 15; return 8 * (i >> 2) + 4 * n + (i & 3); }

struct Unit { int pm, pn; };
struct Gemm { const bf16_t* A; const bf16_t* Bt; int M, N, K; };

struct StaticOrder {
    int nM, nN, nwg, G, c;
    __host__ __device__ void init(int M, int N, int G_, int c_) { nM = M / BM; nN = N / BM; nwg = nM * nN; G = G_; c = c_; }
    __host__ __device__ bool next(int i, Unit& u) const {
        const long L = (long)i * G + c; if (L >= nwg) return false;
        int wgid = (int)L; { const int q = nwg / NXCD, r = nwg % NXCD, xcd = wgid % NXCD, off = wgid / NXCD; wgid = (xcd < r ? xcd * (q + 1) : r * (q + 1) + (xcd - r) * q) + off; }
        const int nig = WGM * nN, gid = wgid / nig, fm = gid * WGM, gsz = (nM - fm) < WGM ? (nM - fm) : WGM;
        u.pm = fm + ((wgid % nig) % gsz); u.pn = (wgid % nig) / gsz; return true;
    }
    __device__ __forceinline__ void a_ready(const Unit&) const {}
    __device__ __forceinline__ void done(const Unit&) const {}
};

__device__ __forceinline__ unsigned cvt_pk_bf16(float lo, float hi) { unsigned r; asm volatile("v_cvt_pk_bf16_f32 %0, %1, %2" : "=v"(r) : "v"(lo), "v"(hi)); return r; }
typedef float f32x2 __attribute__((ext_vector_type(2)));
typedef __bf16 bf16x2_t __attribute__((ext_vector_type(2)));
__device__ __forceinline__ unsigned cvtpk(float lo, float hi) { f32x2 v = {lo, hi}; bf16x2_t b = __builtin_convertvector(v, bf16x2_t); return __builtin_bit_cast(unsigned, b); }
__device__ __forceinline__ float fast_sigmoid(float x) { return __builtin_amdgcn_rcpf(1.0f + __expf(-x)); }
struct EpiBf16Plain {
    static constexpr bool PERM = true, AFTER_DRAIN = false;
    bf16_t* O; int ldc;
    __device__ __forceinline__ void operator()(const f32x4 (&acc)[2][2][4][2], const Unit& u, int wr, int wc, int fr, int fq) const {
        const int row0 = u.pm * BM + wr * 64 + fr, col0 = u.pn * BM + wc * 32 + 8 * fq;
#pragma unroll
        for (int ai = 0; ai < 2; ++ai)
#pragma unroll
            for (int m = 0; m < 4; ++m) { bf16_t* rowp = O + (size_t)(row0 + ai * HALF + m * 16) * ldc + col0;
#pragma unroll
                for (int bj = 0; bj < 2; ++bj) { const f32x4 v0 = acc[ai][bj][m][0], v1 = acc[ai][bj][m][1];
                    u32x4 w; w.x = cvtpk(v0[0], v0[1]); w.y = cvtpk(v0[2], v0[3]); w.z = cvtpk(v1[0], v1[1]); w.w = cvtpk(v1[2], v1[3]);
                    *(u32x4*)(rowp + bj * HALF) = w; } }
    }
};
struct EpiSwiglu {
    static constexpr bool PERM = true, AFTER_DRAIN = false;
    bf16_t* O; int ldc;
    __device__ __forceinline__ void operator()(const f32x4 (&acc)[2][2][4][2], const Unit& u, int wr, int wc, int fr, int fq) const {
        const int row0 = u.pm * BM + wr * 64 + fr, col0 = u.pn * HALF + wc * 32 + 8 * fq;
#pragma unroll
        for (int ai = 0; ai < 2; ++ai)
#pragma unroll
            for (int m = 0; m < 4; ++m) { bf16_t* rowp = O + (size_t)(row0 + ai * HALF + m * 16) * ldc + col0;
                float a[8];
#pragma unroll
                for (int n = 0; n < 2; ++n)
#pragma unroll
                    for (int i = 0; i < 4; ++i) { const float g = acc[ai][0][m][n][i], uu = acc[ai][1][m][n][i]; a[4 * n + i] = g * fast_sigmoid(g) * uu; }
                u32x4 w; w.x = cvtpk(a[0], a[1]); w.y = cvtpk(a[2], a[3]); w.z = cvtpk(a[4], a[5]); w.w = cvtpk(a[6], a[7]);
                *(u32x4*)rowp = w; }
    }
};
struct EpiResid {
    static constexpr bool PERM = false, AFTER_DRAIN = false;
    const float* base; float* out; const float* gate; int gstride; float coef;
    __device__ __forceinline__ void operator()(const f32x4 (&acc)[2][2][4][2], const Unit& u, int wr, int wc, int fr, int fq) const {
        const int row0 = u.pm * BM + wr * 64 + fr, col0 = u.pn * BM + wc * 32 + 4 * fq;
        const float* gb = gate + (size_t)(u.pm >> 5) * gstride;
        f32x4 gv[2][2];
#pragma unroll
        for (int bj = 0; bj < 2; ++bj)
#pragma unroll
            for (int n = 0; n < 2; ++n) gv[bj][n] = *(const f32x4*)(gb + col0 + bj * HALF + n * 16) * coef;
#pragma unroll
        for (int ai = 0; ai < 2; ++ai)
#pragma unroll
            for (int m = 0; m < 4; ++m) { const size_t off = (size_t)(row0 + ai * HALF + m * 16) * 1024 + col0;
#pragma unroll
                for (int bj = 0; bj < 2; ++bj)
#pragma unroll
                    for (int n = 0; n < 2; ++n) { const f32x4 bs = *(const f32x4*)(base + off + bj * HALF + n * 16);
                        *(f32x4*)(out + off + bj * HALF + n * 16) = bs + gv[bj][n] * acc[ai][bj][m][n]; } }
    }
};

template <class Epi, class Sched, bool ALIGN_EPI = false, bool SP2 = false>
__device__ __forceinline__ void gemm_phase(PG8_LAS unsigned char* lds, const Gemm g, const Sched& S, const Epi& E) {
    int tid_ = threadIdx.x; asm volatile("" : "+v"(tid_));
    const int tid = tid_, wid = __builtin_amdgcn_readfirstlane(tid >> 6), lane = tid & 63, wr = wid >> 2, wc = wid & 3, fr = lane & 15, fq = lane >> 4;
    const int K = g.K, nt = K / BK;
    unsigned voffA[2], voffB[2];
#pragma unroll
    for (int i = 0; i < 2; ++i) { int R, C; stage_rc(tid * 16 + i * 8192, R, C); const int Rb = Epi::PERM ? ((R & ~31) + perm32(R & 31)) : R;
        voffA[i] = (unsigned)(R * K + C) * 2u; voffB[i] = (unsigned)(Rb * K + C) * 2u; }
    const size_t kstep = (size_t)(BK * 2);
    const size_t hstep = (size_t)HALF * K * 2;
    const size_t tstep = 2 * hstep;
    const unsigned ldsw = (unsigned)wid * 1024u;
    const int aoff = lds_byte(wr * 64 + fr, fq * 8), boff = lds_byte(wc * 32 + fr, fq * 8);
#define PG8_SA(b, h) (((b) * 2 + (h)) * HTB)
#define PG8_SB(b, h) ((4 + (b) * 2 + (h)) * HTB)
#define PG8_STAGE(bufoff, gbase, voff) do { _Pragma("unroll") for (int _i = 0; _i < 2; ++_i) \
        __builtin_amdgcn_global_load_lds((const unsigned*)((const char*)(gbase) + (voff)[_i]), (PG8_LAS unsigned*)(lds + (bufoff) + ldsw + _i * 8192), 16, 0, 0); } while (0)
#define PG8_LDA(dst, b, h) do { _Pragma("unroll") for (int m = 0; m < 4; ++m) _Pragma("unroll") for (int k = 0; k < 2; ++k) dst[m][k] = *(const PG8_LAS bf16x8*)(lds + PG8_SA(b, h) + aoff + m * 2048 + k * 1024); } while (0)
#define PG8_LDB(dst, b, h) do { _Pragma("unroll") for (int n = 0; n < 2; ++n) _Pragma("unroll") for (int k = 0; k < 2; ++k) dst[n][k] = *(const PG8_LAS bf16x8*)(lds + PG8_SB(b, h) + boff + n * 2048 + k * 1024); } while (0)
#define PG8_MMA(ai, bj, At, Bt) do { __builtin_amdgcn_s_setprio(1); _Pragma("unroll") for (int m = 0; m < 4; ++m) _Pragma("unroll") for (int n = 0; n < 2; ++n) _Pragma("unroll") for (int k = 0; k < 2; ++k) \
        acc[ai][bj][m][n] = __builtin_amdgcn_mfma_f32_16x16x32_bf16(Bt[n][k], At[m][k], acc[ai][bj][m][n], 0, 0, 0); __builtin_amdgcn_s_setprio(0); } while (0)
#define PG8_WAIT_V(n) asm volatile("s_waitcnt vmcnt(" #n ")" ::: "memory")
#define PG8_WAIT_L(n) asm volatile("s_waitcnt lgkmcnt(" #n ")" ::: "memory")
#define PG8_BAR __builtin_amdgcn_s_barrier()
#define PG8_SCHED __builtin_amdgcn_sched_barrier(0)
    Unit cur, nxt; int ui = 0;
    if (!S.next(0, cur)) return;
    f32x4 acc[2][2][4][2];
#pragma unroll
    for (int a = 0; a < 2; ++a)
#pragma unroll
        for (int b = 0; b < 2; ++b)
#pragma unroll
            for (int m = 0; m < 4; ++m)
#pragma unroll
                for (int n = 0; n < 2; ++n) acc[a][b][m][n] = (f32x4){0.f, 0.f, 0.f, 0.f};
    bf16x8 At[4][2], B0[2][2], B1[2][2];
    const char* cA = (const char*)g.A + (size_t)cur.pm * tstep; const char* cB = (const char*)g.Bt + (size_t)cur.pn * tstep;
    S.a_ready(cur);
    if constexpr (SP2) {
        PG8_STAGE(PG8_SB(0, 0), cB, voffB); PG8_STAGE(PG8_SB(0, 1), cB + hstep, voffB); PG8_STAGE(PG8_SA(0, 0), cA, voffA); PG8_STAGE(PG8_SA(0, 1), cA + hstep, voffA);
        if (wr == 1) PG8_BAR;
        PG8_WAIT_V(2); PG8_BAR;
        PG8_STAGE(PG8_SB(1, 0), cB + kstep, voffB); PG8_STAGE(PG8_SA(1, 0), cA + kstep, voffA); PG8_STAGE(PG8_SB(1, 1), cB + hstep + kstep, voffB);
        PG8_WAIT_V(6); PG8_BAR;
    } else {
        PG8_STAGE(PG8_SB(0, 0), cB, voffB); PG8_STAGE(PG8_SA(0, 0), cA, voffA); PG8_STAGE(PG8_SB(0, 1), cB + hstep, voffB); PG8_STAGE(PG8_SA(0, 1), cA + hstep, voffA);
        if (wr == 1) PG8_BAR;
        PG8_WAIT_V(4); PG8_BAR;
        PG8_STAGE(PG8_SB(1, 0), cB + kstep, voffB); PG8_STAGE(PG8_SA(1, 0), cA + kstep, voffA); PG8_STAGE(PG8_SB(1, 1), cB + hstep + kstep, voffB);
        PG8_WAIT_V(6); PG8_BAR;
    }
    for (;;) {
        const bool has_next = S.next(ui + 1, nxt);
        const char* nA = has_next ? (const char*)g.A + (size_t)nxt.pm * tstep : cA; const char* nB = has_next ? (const char*)g.Bt + (size_t)nxt.pn * tstep : cB;
        for (int t = 0; t < nt; t += 2) {
            const bool last = (t == nt - 2);
            const char* a1 = cA + (size_t)(t + 1) * kstep;
            const char* a2 = last ? nA : cA + (size_t)(t + 2) * kstep; const char* b2 = last ? nB : cB + (size_t)(t + 2) * kstep;
            const char* a3 = a2 + kstep; const char* b3 = b2 + kstep;
            if (last && has_next) S.a_ready(nxt);
            if constexpr (SP2) {
            PG8_LDB(B0, 0, 0); PG8_LDB(B1, 0, 1); PG8_SCHED; PG8_LDA(At, 0, 0); PG8_STAGE(PG8_SA(1, 1), a1 + hstep, voffA);
            PG8_WAIT_V(8); PG8_WAIT_L(0); PG8_BAR; PG8_MMA(0, 0, At, B0); PG8_MMA(0, 1, At, B1); PG8_BAR; PG8_SCHED;
            PG8_LDA(At, 0, 1); PG8_STAGE(PG8_SB(0, 0), b2, voffB); PG8_STAGE(PG8_SB(0, 1), b2 + hstep, voffB); PG8_STAGE(PG8_SA(0, 0), a2, voffA);
            PG8_WAIT_V(8); PG8_WAIT_L(0); PG8_BAR; PG8_MMA(1, 0, At, B0); PG8_MMA(1, 1, At, B1); PG8_BAR; PG8_SCHED;
            PG8_LDB(B0, 1, 0); PG8_LDB(B1, 1, 1); PG8_SCHED; PG8_LDA(At, 1, 0); PG8_STAGE(PG8_SA(0, 1), a2 + hstep, voffA);
            PG8_WAIT_V(8); PG8_WAIT_L(0); PG8_BAR; PG8_MMA(0, 0, At, B0); PG8_MMA(0, 1, At, B1); PG8_BAR; PG8_SCHED;
            PG8_LDA(At, 1, 1); PG8_STAGE(PG8_SB(1, 0), b3, voffB); PG8_STAGE(PG8_SB(1, 1), b3 + hstep, voffB); PG8_STAGE(PG8_SA(1, 0), a3, voffA);
            PG8_WAIT_V(8); PG8_WAIT_L(0); PG8_BAR; PG8_MMA(1, 0, At, B0); PG8_MMA(1, 1, At, B1); PG8_BAR; PG8_SCHED;
            } else {
            PG8_LDB(B0, 0, 0); PG8_SCHED; PG8_LDA(At, 0, 0); PG8_STAGE(PG8_SA(1, 1), a1 + hstep, voffA);
            PG8_WAIT_L(8); PG8_BAR; PG8_WAIT_L(0); PG8_MMA(0, 0, At, B0); PG8_BAR; PG8_SCHED;
            PG8_LDB(B1, 0, 1); PG8_STAGE(PG8_SB(0, 0), b2, voffB);
            PG8_BAR; PG8_WAIT_L(0); PG8_MMA(0, 1, At, B1); PG8_BAR;
            PG8_LDA(At, 0, 1); PG8_STAGE(PG8_SA(0, 0), a2, voffA);
            PG8_BAR; PG8_WAIT_L(0); PG8_MMA(1, 0, At, B0); PG8_BAR; PG8_SCHED;
            PG8_STAGE(PG8_SB(0, 1), b2 + hstep, voffB);
            PG8_WAIT_V(6); PG8_BAR; PG8_MMA(1, 1, At, B1); PG8_BAR;
            PG8_LDB(B0, 1, 0); PG8_SCHED; PG8_LDA(At, 1, 0); PG8_STAGE(PG8_SA(0, 1), a2 + hstep, voffA);
            PG8_WAIT_L(8); PG8_BAR; PG8_WAIT_L(0); PG8_MMA(0, 0, At, B0); PG8_BAR; PG8_SCHED;
            PG8_LDB(B1, 1, 1); PG8_STAGE(PG8_SB(1, 0), b3, voffB);
            PG8_BAR; PG8_WAIT_L(0); PG8_MMA(0, 1, At, B1); PG8_BAR;
            PG8_LDA(At, 1, 1); PG8_STAGE(PG8_SA(1, 0), a3, voffA);
            PG8_BAR; PG8_WAIT_L(0); PG8_MMA(1, 0, At, B0); PG8_BAR; PG8_SCHED;
            PG8_STAGE(PG8_SB(1, 1), b3 + hstep, voffB);
            PG8_WAIT_V(6); PG8_BAR; PG8_MMA(1, 1, At, B1); PG8_BAR;
            }
        }
        if constexpr (ALIGN_EPI) { if (wr == 0) PG8_BAR; }
        if constexpr (!Epi::AFTER_DRAIN) { E(acc, cur, wr, wc, fr, fq); S.done(cur); }
        if (!has_next) break;
#pragma unroll
        for (int a = 0; a < 2; ++a)
#pragma unroll
            for (int b = 0; b < 2; ++b)
#pragma unroll
                for (int m = 0; m < 4; ++m)
#pragma unroll
                    for (int n = 0; n < 2; ++n) acc[a][b][m][n] = (f32x4){0.f, 0.f, 0.f, 0.f};
        cur = nxt; cA = nA; cB = nB; ++ui;
        if constexpr (ALIGN_EPI) { if (wr == 1) PG8_BAR; }
    }
    PG8_WAIT_V(0);
    if constexpr (!ALIGN_EPI) { if (wr == 0) PG8_BAR; }
    PG8_BAR;
    if constexpr (Epi::AFTER_DRAIN) { E.fused(acc, cur, wr, wc, fr, fq, lds, wid, lane); S.done(cur); }
#undef PG8_SA
#undef PG8_SB
#undef PG8_STAGE
#undef PG8_LDA
#undef PG8_LDB
#undef PG8_MMA
#undef PG8_WAIT_V
#undef PG8_WAIT_L
#undef PG8_BAR
#undef PG8_SCHED
}
}

#ifndef PG8_SP2
#define PG8_SP2 true
#endif
#ifndef PG8_ALIGN
#define PG8_ALIGN true
#endif
#define GAS __attribute__((address_space(1)))
#define LAS __attribute__((address_space(3)))
typedef unsigned short bf16;
typedef unsigned v4u __attribute__((ext_vector_type(4)));
typedef float f32x4 __attribute__((ext_vector_type(4)));
typedef short bf16x8 __attribute__((ext_vector_type(8)));
typedef GAS unsigned gu32;
typedef GAS unsigned long long gu64;
#define RLX_AGENT __ATOMIC_RELAXED, __HIP_MEMORY_SCOPE_AGENT
#define LDS_WAIT() asm volatile("s_waitcnt lgkmcnt(0)" ::: "memory")
#define VM_WAIT() asm volatile("s_waitcnt vmcnt(0)" ::: "memory")
__device__ __forceinline__ unsigned long long rt() { return __builtin_amdgcn_s_memrealtime(); }
__device__ __forceinline__ unsigned f2bf(float f) { unsigned u = __builtin_bit_cast(unsigned, f); return (u + 0x7fffu + ((u >> 16) & 1u)) >> 16; }
__device__ __forceinline__ unsigned pk2(float lo, float hi) { return f2bf(lo) | (f2bf(hi) << 16); }

#define XB_TMO      128
#define XB_XCNT(j)  (256  + 64 * (j))
#define XB_XSUB(j)  (1280 + 64 * (j))
#define XB_XGEN(j)  (2304 + 64 * (j))
#define XB_TOP      3328
#define XB_TOPGEN   3392
#define XCD_BAR_WORDS 3456
#define XB_SPIN_CAP (1u << 18)

__device__ __forceinline__ unsigned xb_ld(unsigned* p)              { return __hip_atomic_load(p, __ATOMIC_RELAXED, __HIP_MEMORY_SCOPE_AGENT); }
__device__ __forceinline__ unsigned xb_add(unsigned* p, unsigned v) { return __hip_atomic_fetch_add(p, v, __ATOMIC_RELAXED, __HIP_MEMORY_SCOPE_AGENT); }
__device__ __forceinline__ unsigned xb_xcc_id() { return (unsigned)__builtin_amdgcn_s_getreg((3 << 11) | 20) & 0xFu; }
#define XB_SPIN(cond, bar) do { unsigned _sp = 0; while (cond) { __builtin_amdgcn_s_sleep(1); \
    if ((++_sp & 255u) == 0u) { if (xb_ld(&(bar)[XB_TMO])) break; if (_sp > XB_SPIN_CAP) { atomicAdd(&(bar)[XB_TMO], 1u); break; } } } } while (0)

struct XcdBarrier {
    unsigned* bar; unsigned x;
    volatile LAS unsigned* st;
};

__device__ __forceinline__ XcdBarrier xcd_barrier_post(unsigned* bar, volatile LAS unsigned* st) {
    XcdBarrier b; b.bar = bar; b.x = xb_xcc_id(); b.st = st;
    if (threadIdx.x == 0) (void)xb_add(&bar[XB_XCNT(b.x)], 1u);
    return b;
}
__device__ __forceinline__ void xcd_barrier_complete(unsigned* bar, unsigned x, unsigned& nloc, unsigned& nx) {
    const unsigned G = gridDim.x * gridDim.y * gridDim.z;
    unsigned sum, cnt, mine, sp = 0u;
    for (;;) {
        sum = 0u; cnt = 0u; mine = 0u;
#pragma unroll
        for (unsigned j = 0; j < 16; ++j) { const unsigned c = xb_ld(&bar[XB_XCNT(j)]); sum += c; cnt += (c > 0u) ? 1u : 0u; mine = (j == x) ? c : mine; }
        if (sum == G) break;
        __builtin_amdgcn_s_sleep(1);
        if ((++sp & 255u) == 0u) { if (xb_ld(&bar[XB_TMO])) break; if (sp > XB_SPIN_CAP) { atomicAdd(&bar[XB_TMO], 1u); break; } }
    }
    nloc = mine > 0u ? mine : 1u; nx = cnt > 0u ? cnt : 1u;
}

__device__ __forceinline__ void xcd_barrier(const XcdBarrier& b) {
    asm volatile("s_waitcnt vmcnt(0)" ::: "memory");
    __syncthreads();
    if (threadIdx.x == 0) {
        unsigned* bar = b.bar;
        __builtin_amdgcn_s_waitcnt(0);
        unsigned nloc = b.st[0], nx = b.st[1];
        if (nloc == 0u) { xcd_barrier_complete(bar, b.x, nloc, nx); b.st[0] = nloc; b.st[1] = nx; }
        const unsigned old = xb_add(&bar[XB_XSUB(b.x)], 1u);
        const unsigned gen = old / nloc;
        if (old + 1u == (gen + 1u) * nloc) {
            __builtin_amdgcn_fence(__ATOMIC_RELEASE, "agent");
            asm volatile("s_waitcnt vmcnt(0)" ::: "memory");
            const unsigned og = xb_add(&bar[XB_TOP], 1u);
            const unsigned tg = og / nx;
            if (og + 1u == (tg + 1u) * nx) xb_add(&bar[XB_TOPGEN], 1u);
            else XB_SPIN(xb_ld(&bar[XB_TOPGEN]) == tg, bar);
            __builtin_amdgcn_fence(__ATOMIC_ACQUIRE, "agent");
            xb_add(&bar[XB_XGEN(b.x)], 1u);
            asm volatile("s_waitcnt vmcnt(0)" ::: "memory");
        } else {
            XB_SPIN(xb_ld(&bar[XB_XGEN(b.x)]) == gen, bar);
            __builtin_amdgcn_fence(__ATOMIC_ACQUIRE, "agent");
            asm volatile("s_waitcnt vmcnt(0)" ::: "memory");
        }
    }
    __syncthreads();
}

#ifndef EN_P0
#define EN_P0 1
#endif
#ifndef EN_G1
#define EN_G1 1
#endif
#ifndef EN_G2
#define EN_G2 1
#endif
#ifndef EN_G3
#define EN_G3 1
#endif
#ifndef EN_MIX
#define EN_MIX 1
#endif
#ifndef MK_PER_PHASE
#define MK_PER_PHASE 0
#endif
constexpr int NWAVES = 8;
constexpr int BATCH = 2, SEQ = 8192, DM = 1024, DEPTH = 2, DFF = 2816, NGU = 2 * DFF, NIN = 2048, NMODV = 9 * DM;
constexpr int M = BATCH * SEQ;
constexpr float RMS_EPS = 1e-6f;
constexpr int NPHASE = 2 + 10 * DEPTH;

enum { IN_X = 0, IN_C, IN_WMOD, IN_BMOD, IN_GNORM, IN_GU1, IN_DN1, IN_GU2, IN_DN2, IN_WIN, IN_WOUT, IN_SINKS, IN_LCW, IN_LCB, IN_GAW, IN_GAB, IN_GXW, IN_GXB, IN_LAM, IN_SCW, IN_GFIN, N_IN };

constexpr size_t MiB = 1u << 20;
constexpr size_t WS_CTL = 0, CTL_ZERO_BYTES = 2 * MiB;
constexpr size_t WS_GRAN = 1 * MiB;
constexpr size_t WS_MOD = 2 * MiB;
constexpr size_t WS_PAR = 2 * MiB + 512 * 1024;
constexpr int P_GNORM = 0, P_GFIN = 6144, P_SINKS = 7168, P_LCW = 7184, P_LCB = 9232, P_GAB = 9744, P_GXB = 10256, P_SP = 10768, P_SCW = 11280, P_GAW = 12816, P_GXW = 45584, P_END = 78352;
static_assert(WS_PAR + (size_t)P_END * 4 <= 3 * MiB, "ws map (params)");
constexpr size_t WS_WGU = 3 * MiB;
constexpr size_t WS_WDN = 47 * MiB;
constexpr size_t WS_WIN = 69 * MiB;
constexpr size_t WS_WOUT = 77 * MiB;
constexpr size_t WS_H = 81 * MiB;
constexpr size_t WS_ACT = 113 * MiB;
constexpr size_t WS_PROJ = 113 * MiB;
constexpr size_t WS_Y = 177 * MiB;
constexpr size_t WS_END = 209 * MiB;
static_assert(WS_WGU + 4 * (size_t)NGU * DM * 2 <= WS_WDN && WS_WDN + 4 * (size_t)DM * DFF * 2 <= WS_WIN && WS_WIN + 2 * (size_t)NIN * DM * 2 <= WS_WOUT && WS_WOUT + 2 * (size_t)DM * DM * 2 <= WS_H, "ws map (weights)");
static_assert(WS_H + (size_t)M * DM * 2 <= WS_ACT && WS_ACT + (size_t)M * DFF * 2 <= WS_END && WS_PROJ + (size_t)M * NIN * 2 <= WS_Y && WS_Y + (size_t)M * DM * 2 <= WS_END, "ws map (activations)");
constexpr int CW_TMO = 0, CW_CODE = 1, CW_BAR = 4096;

constexpr int RING_OFF = 0, RING_BYTES = 131072;
constexpr int LDSCTL_OFF = RING_BYTES, MISC_OFF = LDSCTL_OFF + 320;
constexpr int LDS_BYTES = 147456;

typedef unsigned u32x4 __attribute__((ext_vector_type(4)));
typedef float f32x16 __attribute__((ext_vector_type(16)));
#define DI __device__ __forceinline__
#define MFMA32(a, b, c) __builtin_amdgcn_mfma_f32_32x32x16_bf16((a), (b), (c), 0, 0, 0)

struct Frame {
    LAS unsigned char* lds;
    volatile LAS unsigned* MISC;
    gu32* ctl;
    int vcu, G, bx;
    float* out; unsigned char* ws; const float* xin;
};
struct Args { const float* in[N_IN]; float* out; unsigned char* ws; int ph_lo, ph_hi, li, pad; };
#define FRESH_IDS(F) int tid = threadIdx.x; asm volatile("" : "+v"(tid)); const int lane = tid & 63, w = __builtin_amdgcn_readfirstlane(tid >> 6); (void)lane; (void)w
#define PARF(F) ((const float*)((F).ws + WS_PAR))
DI float bf2f(short v) { return __builtin_bit_cast(float, (unsigned)(unsigned short)v << 16); }
DI unsigned cvtpk2(float lo, float hi) { return pg8::cvtpk(lo, hi); }
DI float lane_read(float v, int src_lane) { return __builtin_bit_cast(float, __builtin_amdgcn_ds_bpermute(src_lane << 2, __builtin_bit_cast(int, v))); }
DI float wave_sum(float v, int lane) {
#pragma unroll
    for (int o = 1; o < 64; o <<= 1) v += lane_read(v, lane ^ o);
    return v;
}
DI void set_tmo(Frame& F, unsigned code) {
    unsigned expect = 0u; __hip_atomic_compare_exchange_strong((unsigned*)(F.ctl + CW_CODE), &expect, code, __ATOMIC_RELAXED, __ATOMIC_RELAXED, __HIP_MEMORY_SCOPE_AGENT);
    __hip_atomic_store(F.ctl + CW_TMO, 1u, RLX_AGENT);
}

DI void tr_item(const float* W, int K, int N, bf16* WT, bool gu, LAS float* scr, int item, int lane) {
    const int nblk = N / 32, kb = item / nblk, nb = item % nblk, k0 = 64 * kb, n0 = 32 * nb;
    int c0 = n0; if (gu) { const int pn = n0 >> 8, bj = (n0 >> 7) & 1, j0 = n0 & 127; c0 = bj * DFF + 128 * pn + j0; }
#pragma unroll 8
    for (int i = 0; i < 32; ++i) { const int kk = 2 * i + (lane >> 5); scr[kk * 33 + (lane & 31)] = W[(size_t)(k0 + kk) * N + c0 + (lane & 31)]; }
    LDS_WAIT(); asm volatile("" ::: "memory");
    const int c = lane & 7;
#pragma unroll
    for (int j = 0; j < 4; ++j) { const int n = (lane >> 3) + 8 * j; const LAS float* s = scr + (8 * c) * 33 + n;
        v4u o; o.x = pk2(s[0 * 33], s[1 * 33]); o.y = pk2(s[2 * 33], s[3 * 33]); o.z = pk2(s[4 * 33], s[5 * 33]); o.w = pk2(s[6 * 33], s[7 * 33]);
        *(GAS v4u*)(WT + (size_t)(n0 + n) * K + k0 + 8 * c) = o; }
    LDS_WAIT(); asm volatile("" ::: "memory");
}
DI void p0_phase(Frame& F, const Args& A) {
    FRESH_IDS(F);
    for (int it = F.vcu; it < DEPTH * 72; it += F.G) {
        LAS float* SC = (LAS float*)(F.lds); LAS float* PART = (LAS float*)(F.lds + 8192);
        for (int i = tid; i < BATCH * DM; i += NWAVES * 64) { const float cv = A.in[IN_C][i]; SC[i] = cv / (1.0f + __expf(-cv)); }
        __syncthreads();
        const int l = it / 72, cg = it % 72;
        const float* W = A.in[IN_WMOD] + (size_t)l * DM * NMODV + 128 * cg + 2 * lane;
        float a00 = 0.f, a01 = 0.f, a10 = 0.f, a11 = 0.f;
        const int k0 = w * 128;
#pragma unroll 8
        for (int k = 0; k < 128; ++k) { const float2 w = *(const float2*)(W + (size_t)(k0 + k) * NMODV); const float s0 = SC[k0 + k], s1 = SC[DM + k0 + k];
            a00 += s0 * w.x; a01 += s0 * w.y; a10 += s1 * w.x; a11 += s1 * w.y; }
        PART[(w * 2 + 0) * 128 + 2 * lane] = a00; PART[(w * 2 + 0) * 128 + 2 * lane + 1] = a01;
        PART[(w * 2 + 1) * 128 + 2 * lane] = a10; PART[(w * 2 + 1) * 128 + 2 * lane + 1] = a11;
        __syncthreads();
        if (tid < 256) { const int b = tid >> 7, col = tid & 127; float s = 0.f;
#pragma unroll
            for (int w = 0; w < 8; ++w) s += PART[(w * 2 + b) * 128 + col];
            float* mod = (float*)(F.ws + WS_MOD);
            mod[(size_t)(l * BATCH + b) * NMODV + 128 * cg + col] = s + A.in[IN_BMOD][(size_t)l * NMODV + 128 * cg + col]; }
        __syncthreads();
    }
    {
        float* par = (float*)(F.ws + WS_PAR); const int gt = F.vcu * (NWAVES * 64) + tid, NGT = F.G * NWAVES * 64;
        for (int i = gt; i < DEPTH * 3 * DM; i += NGT) par[P_GNORM + i] = A.in[IN_GNORM][i];
        for (int i = gt; i < DM; i += NGT) par[P_GFIN + i] = A.in[IN_GFIN][i];
        for (int i = gt; i < DEPTH * 8; i += NGT) par[P_SINKS + i] = A.in[IN_SINKS][i];
        for (int i = gt; i < DEPTH * 4 * 256; i += NGT) par[P_LCW + i] = A.in[IN_LCW][i];
        for (int i = gt; i < DEPTH * 256; i += NGT) { par[P_LCB + i] = A.in[IN_LCB][i]; par[P_GAB + i] = A.in[IN_GAB][i]; par[P_GXB + i] = A.in[IN_GXB][i]; par[P_SP + i] = log1pf(expf(-A.in[IN_LAM][i])); }
        for (int i = gt; i < DEPTH * 3 * 256; i += NGT) par[P_SCW + i] = A.in[IN_SCW][i];
        for (int i = gt; i < DEPTH * 4 * 4096; i += NGT) { par[P_GAW + i] = A.in[IN_GAW][i]; par[P_GXW + i] = A.in[IN_GXW][i]; }
    }
    LAS float* scr = (LAS float*)(F.lds + RING_OFF + w * 16384);
    const int gw = F.vcu * NWAVES + w, NGW = F.G * NWAVES;
    constexpr int I_GU = (DM / 64) * (NGU / 32), I_DN = (DFF / 64) * (DM / 32), I_IN = (DM / 64) * (NIN / 32), I_OUT = (DM / 64) * (DM / 32);
    constexpr int NITEMS = 4 * I_GU + 4 * I_DN + 2 * I_IN + 2 * I_OUT;
    for (int it = gw; it < NITEMS; it += NGW) {
        int r = it;
        if (r < 4 * I_GU) { const int m = r / I_GU, i = r % I_GU, l = m >> 1, f = m & 1;
            tr_item((f ? A.in[IN_GU2] : A.in[IN_GU1]) + (size_t)l * DM * NGU, DM, NGU, (bf16*)(F.ws + WS_WGU) + (size_t)m * NGU * DM, true, scr, i, lane); continue; }
        r -= 4 * I_GU;
        if (r < 4 * I_DN) { const int m = r / I_DN, i = r % I_DN, l = m >> 1, f = m & 1;
            tr_item((f ? A.in[IN_DN2] : A.in[IN_DN1]) + (size_t)l * DFF * DM, DFF, DM, (bf16*)(F.ws + WS_WDN) + (size_t)m * DM * DFF, false, scr, i, lane); continue; }
        r -= 4 * I_DN;
        if (r < 2 * I_IN) { const int l = r / I_IN, i = r % I_IN;
            tr_item(A.in[IN_WIN] + (size_t)l * DM * NIN, DM, NIN, (bf16*)(F.ws + WS_WIN) + (size_t)l * NIN * DM, false, scr, i, lane); continue; }
        r -= 2 * I_IN;
        { const int l = r / I_OUT, i = r % I_OUT;
            tr_item(A.in[IN_WOUT] + (size_t)l * DM * DM, DM, DM, (bf16*)(F.ws + WS_WOUT) + (size_t)l * DM * DM, false, scr, i, lane); }
    }
}

DI void norm_phase(Frame& F, const float* src, int l, int sub) {
    FRESH_IDS(F);
    const int gw = F.vcu * NWAVES + w, NGW = F.G * NWAVES;
    const float* mod = (const float*)(F.ws + WS_MOD);
    bf16* H = (bf16*)(F.ws + WS_H);
    const float* gn = PARF(F) + P_GNORM + (l * 3 + sub) * DM;
    for (int m = gw; m < M; m += NGW) {
        const int b = m >> 13;
        const GAS f32x4* xr = (const GAS f32x4*)(src + (size_t)m * DM) + lane;
        const float* shp = mod + (size_t)(l * BATCH + b) * NMODV + (3 * sub) * DM; const float* scp = shp + DM;
        f32x4 v[4]; float s = 0.f;
#pragma unroll
        for (int j = 0; j < 4; ++j) { v[j] = xr[64 * j]; s += (v[j].x * v[j].x + v[j].y * v[j].y) + (v[j].z * v[j].z + v[j].w * v[j].w); }
        const float rstd = 1.0f / sqrtf(wave_sum(s, lane) * (1.f / DM) + RMS_EPS);
        GAS unsigned long long* o8 = (GAS unsigned long long*)(H + (size_t)m * DM) + lane;
#pragma unroll
        for (int j = 0; j < 4; ++j) { const int k = 4 * lane + 256 * j;
            const f32x4 g4 = *(const f32x4*)(gn + k), sc4 = *(const f32x4*)(scp + k), sh4 = *(const f32x4*)(shp + k);
            const f32x4 o = v[j] * rstd * g4 * (sc4 + 1.0f) + sh4;
            o8[64 * j] = (unsigned long long)cvtpk2(o.x, o.y) | ((unsigned long long)cvtpk2(o.z, o.w) << 32); }
    }
}
DI void final_phase(Frame& F, bool poison) {
    FRESH_IDS(F);
    const int gw = F.vcu * NWAVES + w, NGW = F.G * NWAVES;
    const float* gn = PARF(F) + P_GFIN; const float qnan = __builtin_nanf("");
    for (int m = gw; m < M; m += NGW) {
        GAS f32x4* xr = (GAS f32x4*)(F.out + (size_t)m * DM) + lane;
        f32x4 v[4]; float s = 0.f;
#pragma unroll
        for (int j = 0; j < 4; ++j) { v[j] = xr[64 * j]; s += (v[j].x * v[j].x + v[j].y * v[j].y) + (v[j].z * v[j].z + v[j].w * v[j].w); }
        const float rstd = 1.0f / sqrtf(wave_sum(s, lane) * (1.f / DM) + RMS_EPS);
#pragma unroll
        for (int j = 0; j < 4; ++j) { const f32x4 g4 = *(const f32x4*)(gn + 4 * lane + 256 * j); f32x4 o = v[j] * rstd * g4; if (poison) o = (f32x4){qnan, qnan, qnan, qnan}; xr[64 * j] = o; }
    }
}

namespace mixp {
constexpr int KROW = 144;
constexpr int L_K = 0, L_V = 256 * KROW;
constexpr int XROW = 68;
constexpr int L_XC = 0, L_A = 128 * XROW * 4, L_WA = 2 * L_A, L_WX = L_WA + 64 * KROW, L_SEG = L_WX + 64 * KROW, L_HIN = L_SEG + 4096, L_END = L_HIN + 512;
static_assert(L_END <= RING_BYTES && L_V + 256 * KROW <= L_HIN, "mixer LDS map");
DI int crow(int i, int h) { return (i & 3) + 8 * (i >> 2) + 4 * h; }
DI float gelu_tanh(float x) { const float z = 0.7978845608028654f * (x + 0.044715f * x * x * x); const float t = 1.0f - 2.0f * __builtin_amdgcn_rcpf(1.0f + __expf(2.0f * z)); return 0.5f * x * (1.0f + t); }

template <bool PASS2>
DI void lru_head(Frame& F, int l, int b, int blk, int head, int hl, const bf16* PROJ, bf16* Y, gu64* gran) {
    FRESH_IDS(F);
    LAS unsigned char* lds = F.lds;
    LAS float* XC = (LAS float*)(lds + L_XC); LAS float* AL = (LAS float*)(lds + L_A); LAS float* SEG = (LAS float*)(lds + L_SEG);
    const long rowbase = (long)b * SEQ + blk * 128;
    const int ch0 = 64 * head;
    {
        const float* cw = PARF(F) + P_LCW + l * 4 * 256 + ch0; const float* cb = PARF(F) + P_LCB + l * 256 + ch0;
#pragma unroll
        for (int it = 0; it < 2; ++it) {
            const int idx = tid + 512 * it, t = idx >> 3, c8 = (idx & 7) * 8;
            float acc[8];
            { const f32x4 b0 = *(const f32x4*)(cb + c8), b1 = *(const f32x4*)(cb + c8 + 4); acc[0] = b0.x; acc[1] = b0.y; acc[2] = b0.z; acc[3] = b0.w; acc[4] = b1.x; acc[5] = b1.y; acc[6] = b1.z; acc[7] = b1.w; }
#pragma unroll
            for (int k = 0; k < 4; ++k) { const int tt = t - 3 + k;
                if (blk > 0 || tt >= 0) {
                    const bf16x8 v = *(const bf16x8*)(PROJ + (rowbase + tt) * NIN + 768 + ch0 + c8);
                    const f32x4 w0 = *(const f32x4*)(cw + k * 256 + c8), w1 = *(const f32x4*)(cw + k * 256 + c8 + 4);
                    acc[0] += w0.x * bf2f(v[0]); acc[1] += w0.y * bf2f(v[1]); acc[2] += w0.z * bf2f(v[2]); acc[3] += w0.w * bf2f(v[3]);
                    acc[4] += w1.x * bf2f(v[4]); acc[5] += w1.y * bf2f(v[5]); acc[6] += w1.z * bf2f(v[6]); acc[7] += w1.w * bf2f(v[7]); } }
            *(LAS f32x4*)(XC + t * XROW + c8) = (f32x4){acc[0], acc[1], acc[2], acc[3]};
            *(LAS f32x4*)(XC + t * XROW + c8 + 4) = (f32x4){acc[4], acc[5], acc[6], acc[7]};
        }
        const float* ga = PARF(F) + P_GAW + (l * 4 + head) * 4096; const float* gx = PARF(F) + P_GXW + (l * 4 + head) * 4096;
        LAS unsigned short* WA = (LAS unsigned short*)(lds + L_WA); LAS unsigned short* WX = (LAS unsigned short*)(lds + L_WX);
#pragma unroll
        for (int k = 0; k < 8; ++k) { const int idx = tid + 512 * k, d = idx >> 6, e = idx & 63;
            WA[e * (KROW / 2) + d] = (unsigned short)f2bf(ga[idx]); WX[e * (KROW / 2) + d] = (unsigned short)f2bf(gx[idx]); }
    }
    __syncthreads();
    {
        const int tt = w & 3, et = w >> 2, r = lane & 31, h = lane >> 5;
        f32x16 accR, accI;
#pragma unroll
        for (int i = 0; i < 16; ++i) { accR[i] = 0.f; accI[i] = 0.f; }
#pragma unroll
        for (int ks = 0; ks < 4; ++ks) {
            const f32x4 x0 = *(const LAS f32x4*)(XC + (32 * tt + r) * XROW + 16 * ks + 8 * h), x1 = *(const LAS f32x4*)(XC + (32 * tt + r) * XROW + 16 * ks + 8 * h + 4);
            u32x4 ap; ap.x = cvtpk2(x0.x, x0.y); ap.y = cvtpk2(x0.z, x0.w); ap.z = cvtpk2(x1.x, x1.y); ap.w = cvtpk2(x1.z, x1.w);
            const bf16x8 a = __builtin_bit_cast(bf16x8, ap);
            const bf16x8 ba = *(const LAS bf16x8*)(lds + L_WA + (32 * et + r) * KROW + (16 * ks + 8 * h) * 2);
            const bf16x8 bx = *(const LAS bf16x8*)(lds + L_WX + (32 * et + r) * KROW + (16 * ks + 8 * h) * 2);
            accR = MFMA32(a, ba, accR); accI = MFMA32(a, bx, accI);
        }
        float xcv[16];
#pragma unroll
        for (int i = 0; i < 16; ++i) xcv[i] = XC[(32 * tt + crow(i, h)) * XROW + 32 * et + r];
        __syncthreads();
        const int c = ch0 + 32 * et + r;
        const float bga = (PARF(F) + P_GAB)[l * 256 + c], bgx = (PARF(F) + P_GXB)[l * 256 + c], sp = (PARF(F) + P_SP)[l * 256 + c];
#pragma unroll
        for (int i = 0; i < 16; ++i) { const int t = 32 * tt + crow(i, h);
            const float rg = 1.0f / (1.0f + expf(-(accR[i] + bga))), ig = 1.0f / (1.0f + expf(-(accI[i] + bgx)));
            const float la = -8.0f * rg * sp, a = expf(la);
            float mult = sqrtf(-expm1f(2.0f * la)); if (blk == 0 && t == 0) mult = 1.0f;
            AL[t * XROW + 32 * et + r] = a; XC[t * XROW + 32 * et + r] = mult * (ig * xcv[i]); }
    }
    __syncthreads();
    {
        float Ap = 1.f, Hs = 0.f;
#pragma unroll
        for (int s = 0; s < 16; ++s) { const int o = (16 * w + s) * XROW + lane; const float a = AL[o], u = XC[o]; Hs = a * Hs + u; Ap *= a; if (PASS2) { XC[o] = Hs; AL[o] = Ap; } }
        SEG[(w * 64 + lane) * 2] = Ap; SEG[(w * 64 + lane) * 2 + 1] = Hs;
    }
    __syncthreads();
    if (!PASS2) {
        if (tid < 64) { float A = 1.f, Hh = 0.f;
#pragma unroll
            for (int s = 0; s < 8; ++s) { const float As = SEG[(s * 64 + tid) * 2], Hv = SEG[(s * 64 + tid) * 2 + 1]; Hh = As * Hh + Hv; A *= As; }
            gu64* g = gran + ((size_t)((l * BATCH + b) * 64 + blk) * 256 + ch0 + tid) * 2; const unsigned long long ep = (unsigned long long)(l + 1) << 32;
            __hip_atomic_store(g, ep | __float_as_uint(A), RLX_AGENT); __hip_atomic_store(g + 1, ep | __float_as_uint(Hh), RLX_AGENT); }
        __syncthreads();
    } else {
        const LAS float* HIN = (const LAS float*)(lds + L_HIN);
        float hin = HIN[64 * hl + lane];
        for (int s = 0; s < w; ++s) hin = SEG[(s * 64 + lane) * 2] * hin + SEG[(s * 64 + lane) * 2 + 1];
#pragma unroll
        for (int s = 0; s < 16; ++s) { const int o = (16 * w + s) * XROW + lane; XC[o] = XC[o] + AL[o] * hin; }
        __syncthreads();
#pragma unroll
        for (int it = 0; it < 2; ++it) {
            const int idx = tid + 512 * it, t = idx >> 3, c8 = (idx & 7) * 8;
            const f32x4 h0 = *(const LAS f32x4*)(XC + t * XROW + c8), h1 = *(const LAS f32x4*)(XC + t * XROW + c8 + 4);
            const bf16x8 g = *(const bf16x8*)(PROJ + (rowbase + t) * NIN + 1024 + ch0 + c8);
            u32x4 o; o.x = cvtpk2(gelu_tanh(bf2f(g[0])) * h0.x, gelu_tanh(bf2f(g[1])) * h0.y); o.y = cvtpk2(gelu_tanh(bf2f(g[2])) * h0.z, gelu_tanh(bf2f(g[3])) * h0.w);
            o.z = cvtpk2(gelu_tanh(bf2f(g[4])) * h1.x, gelu_tanh(bf2f(g[5])) * h1.y); o.w = cvtpk2(gelu_tanh(bf2f(g[6])) * h1.z, gelu_tanh(bf2f(g[7])) * h1.w);
            *(u32x4*)(Y + (rowbase + t) * DM + 512 + ch0 + c8) = o;
        }
        __syncthreads();
    }
}

DI void attn(Frame& F, int l, int b, int blk, int kvh, const bf16* PROJ, bf16* Y) {
    FRESH_IDS(F);
    LAS unsigned char* lds = F.lds; const int r = lane & 31, h = lane >> 5;
    const long rowbase = (long)b * SEQ + blk * 128;
#pragma unroll
    for (int it = 0; it < 4; ++it) { const int idx = tid + 512 * it, row = idx >> 3, ch = idx & 7;
        u32x4 kv = (u32x4){0u, 0u, 0u, 0u}, vv = (u32x4){0u, 0u, 0u, 0u};
        if (blk > 0 || row >= 128) { const bf16* p = PROJ + (rowbase - 128 + row) * NIN + 512 + kvh * 64 + ch * 8; kv = *(const u32x4*)p; vv = *(const u32x4*)(p + 128); }
        *(LAS u32x4*)(lds + L_K + row * KROW + ch * 16) = kv; *(LAS u32x4*)(lds + L_V + row * KROW + ch * 16) = vv; }
    __syncthreads();
    const int g = w >> 1, hq = 4 * kvh + g; const float slope = exp2f(-(float)(hq + 1)); const float sink = (PARF(F) + P_SINKS)[l * 8 + hq];
#pragma unroll 1
    for (int sub = 0; sub < 2; ++sub) {
        const int r0 = 64 * (w & 1) + 32 * sub, kt0 = r0 >> 5;
        bf16x8 q[4];
#pragma unroll
        for (int ks = 0; ks < 4; ++ks) q[ks] = *(const bf16x8*)(PROJ + (rowbase + r0 + r) * NIN + hq * 64 + 16 * ks + 8 * h);
        f32x16 S[5];
#pragma unroll
        for (int jt = 0; jt < 5; ++jt) {
#pragma unroll
            for (int i = 0; i < 16; ++i) S[jt][i] = 0.f;
#pragma unroll
            for (int ks = 0; ks < 4; ++ks) { const bf16x8 a = *(const LAS bf16x8*)(lds + L_K + (32 * (kt0 + jt) + r) * KROW + (16 * ks + 8 * h) * 2); S[jt] = MFMA32(a, q[ks], S[jt]); }
        }
        const int qi = r0 + r; float mx = sink;
#pragma unroll
        for (int jt = 0; jt < 5; ++jt)
#pragma unroll
            for (int i = 0; i < 16; ++i) { const int kj = 32 * (kt0 + jt) + crow(i, h), dist = qi + 128 - kj; const bool valid = (dist >= 0) && (dist < 128) && (blk > 0 || kj >= 128);
                const float s = valid ? S[jt][i] * 0.125f - slope * (float)dist : -1e30f; S[jt][i] = s; mx = fmaxf(mx, s); }
        mx = fmaxf(mx, lane_read(mx, lane ^ 32));
        float ls = 0.f; u32x4 PP[5][2];
#pragma unroll
        for (int jt = 0; jt < 5; ++jt) {
#pragma unroll
            for (int i = 0; i < 16; ++i) { const float p = __expf(S[jt][i] - mx); S[jt][i] = p; ls += p; }
#pragma unroll
            for (int s2 = 0; s2 < 2; ++s2) { PP[jt][s2].x = cvtpk2(S[jt][8 * s2 + 0], S[jt][8 * s2 + 1]); PP[jt][s2].y = cvtpk2(S[jt][8 * s2 + 2], S[jt][8 * s2 + 3]); PP[jt][s2].z = cvtpk2(S[jt][8 * s2 + 4], S[jt][8 * s2 + 5]); PP[jt][s2].w = cvtpk2(S[jt][8 * s2 + 6], S[jt][8 * s2 + 7]); }
        }
        ls += lane_read(ls, lane ^ 32);
        const float inv = 1.0f / (ls + __expf(sink - mx));
        f32x16 O0, O1;
#pragma unroll
        for (int i = 0; i < 16; ++i) { O0[i] = 0.f; O1[i] = 0.f; }
#pragma unroll
        for (int jt = 0; jt < 5; ++jt)
#pragma unroll
            for (int s2 = 0; s2 < 2; ++s2) {
                const bf16x8 pa = __builtin_bit_cast(bf16x8, PP[jt][s2]);
                bf16x8 v0, v1;
#pragma unroll
                for (int j = 0; j < 8; ++j) { const int key = 32 * (kt0 + jt) + 16 * s2 + 8 * (j >> 2) + 4 * h + (j & 3);
                    v0[j] = *(const LAS short*)(lds + L_V + key * KROW + r * 2); v1[j] = *(const LAS short*)(lds + L_V + key * KROW + (32 + r) * 2); }
                O0 = MFMA32(pa, v0, O0); O1 = MFMA32(pa, v1, O1);
                __builtin_amdgcn_sched_barrier(0);
            }
#pragma unroll
        for (int i = 0; i < 16; ++i) { const int qrow = crow(i, h); const float iq = lane_read(inv, qrow);
            bf16* yp = Y + (rowbase + r0 + qrow) * DM + hq * 64 + r;
            yp[0] = (bf16)f2bf(O0[i] * iq); yp[32] = (bf16)f2bf(O1[i] * iq); }
    }
    __syncthreads();
}

DI void sconv(Frame& F, int l, int b, int blk, int kvh, const bf16* PROJ, bf16* Y) {
    FRESH_IDS(F);
    const long rowbase = (long)b * SEQ + blk * 128;
    const float* scw = PARF(F) + P_SCW + l * 3 * 256;
#pragma unroll
    for (int it = 0; it < 4; ++it) {
        const int idx = tid + 512 * it, t = idx >> 4, c = 128 * kvh + (idx & 15) * 8;
        float acc[8];
#pragma unroll
        for (int i = 0; i < 8; ++i) acc[i] = 0.f;
#pragma unroll
        for (int k = 0; k < 3; ++k) { const int tt = t - 2 + k;
            if (blk > 0 || tt >= 0) {
                const bf16* p = PROJ + (rowbase + tt) * NIN + c;
                const bf16x8 sc = *(const bf16x8*)(p + 1536), sx = *(const bf16x8*)(p + 1792);
                const f32x4 w0 = *(const f32x4*)(scw + k * 256 + c), w1 = *(const f32x4*)(scw + k * 256 + c + 4);
                acc[0] += w0.x * (bf2f(sc[0]) * bf2f(sx[0])); acc[1] += w0.y * (bf2f(sc[1]) * bf2f(sx[1])); acc[2] += w0.z * (bf2f(sc[2]) * bf2f(sx[2])); acc[3] += w0.w * (bf2f(sc[3]) * bf2f(sx[3]));
                acc[4] += w1.x * (bf2f(sc[4]) * bf2f(sx[4])); acc[5] += w1.y * (bf2f(sc[5]) * bf2f(sx[5])); acc[6] += w1.z * (bf2f(sc[6]) * bf2f(sx[6])); acc[7] += w1.w * (bf2f(sc[7]) * bf2f(sx[7])); } }
        const bf16x8 sb = *(const bf16x8*)(PROJ + (rowbase + t) * NIN + 1280 + c);
        u32x4 o; o.x = cvtpk2(bf2f(sb[0]) * acc[0], bf2f(sb[1]) * acc[1]); o.y = cvtpk2(bf2f(sb[2]) * acc[2], bf2f(sb[3]) * acc[3]);
        o.z = cvtpk2(bf2f(sb[4]) * acc[4], bf2f(sb[5]) * acc[5]); o.w = cvtpk2(bf2f(sb[6]) * acc[6], bf2f(sb[7]) * acc[7]);
        *(u32x4*)(Y + (rowbase + t) * DM + 768 + c) = o;
    }
}

DI void gather_carry(Frame& F, int l, int b, int blk, int kvh, gu64* gran) {
    FRESH_IDS(F);
    LAS float* HIN = (LAS float*)(F.lds + L_HIN);
    if (tid < 128) {
        float hc = 0.f;
        gu64* gp = gran + ((size_t)((l * BATCH + b) * 64) * 256 + 128 * kvh + tid) * 2;
        const unsigned ep = (unsigned)(l + 1);
        for (int j0 = 0; j0 < blk; j0 += 8) {
            unsigned long long ga[8], gh[8]; unsigned spins = 0u;
            for (;;) { bool ok = true;
#pragma unroll
                for (int k = 0; k < 8; ++k) if (j0 + k < blk) { ga[k] = __hip_atomic_load(gp + (size_t)(j0 + k) * 512, RLX_AGENT); gh[k] = __hip_atomic_load(gp + (size_t)(j0 + k) * 512 + 1, RLX_AGENT);
                    ok = ok && ((unsigned)(ga[k] >> 32) == ep) && ((unsigned)(gh[k] >> 32) == ep); }
                if (__all(ok)) break;
                if (++spins > (1u << 16)) { if (lane == 0) set_tmo(F, 0x500u | (unsigned)blk); break; }
                __builtin_amdgcn_s_sleep(4);
            }
#pragma unroll
            for (int k = 0; k < 8; ++k) if (j0 + k < blk) hc = __uint_as_float((unsigned)ga[k]) * hc + __uint_as_float((unsigned)gh[k]);
        }
        HIN[tid] = hc;
    }
    __syncthreads();
}

DI void mix_phase(Frame& F, int l) {
    const bf16* PROJ = (const bf16*)(F.ws + WS_PROJ); bf16* Y = (bf16*)(F.ws + WS_Y); gu64* gran = (gu64*)(F.ws + WS_GRAN);
    for (int u = F.vcu; u < 256; u += F.G) {
        const int b = u >> 7, blk = (u >> 1) & 63, kvh = u & 1;
#ifndef EN_LRU
#define EN_LRU 1
#endif
#ifndef EN_ATT
#define EN_ATT 1
#endif
#ifndef EN_SC
#define EN_SC 1
#endif
        if (EN_LRU) { lru_head<false>(F, l, b, blk, 2 * kvh, 0, PROJ, Y, gran);
        lru_head<false>(F, l, b, blk, 2 * kvh + 1, 1, PROJ, Y, gran); }
        if (EN_ATT) attn(F, l, b, blk, kvh, PROJ, Y);
        if (EN_SC) sconv(F, l, b, blk, kvh, PROJ, Y);
        if (EN_LRU) { gather_carry(F, l, b, blk, kvh, gran);
        lru_head<true>(F, l, b, blk, 2 * kvh, 0, PROJ, Y, gran);
        lru_head<true>(F, l, b, blk, 2 * kvh + 1, 1, PROJ, Y, gran); }
    }
}
}

__global__ void __launch_bounds__(NWAVES * 64, 2) trunk_fwd(Args args) {
    extern __shared__ __attribute__((aligned(16))) unsigned char lds[];
    Frame F;
    F.lds = (LAS unsigned char*)lds;
    F.MISC = (volatile LAS unsigned*)(F.lds + MISC_OFF);
    F.G = gridDim.x; F.bx = blockIdx.x; { const int bx = blockIdx.x; F.vcu = (F.G % 8 == 0) ? (bx % 8) * (F.G / 8) + bx / 8 : bx; }
    F.ws = args.ws; F.out = args.out; F.xin = args.in[IN_X]; F.ctl = (gu32*)(args.ws + WS_CTL);
    for (int u = threadIdx.x; u < (LDS_BYTES - LDSCTL_OFF) / 4; u += NWAVES * 64) ((LAS unsigned*)(F.lds + LDSCTL_OFF))[u] = 0u;
    __syncthreads();
    XcdBarrier bar; bar.bar = (unsigned*)(F.ctl + CW_BAR); bar.x = 0; bar.st = nullptr;
    if (!MK_PER_PHASE) bar = xcd_barrier_post((unsigned*)(F.ctl + CW_BAR), F.MISC + 8);

    const int lo = args.ph_lo, hi = args.ph_hi;
    if (lo == 0) { if (EN_P0) p0_phase(F, args); if (1 < hi) { XcdBarrier bb = bar; asm volatile("" : "+s"(bb.bar)); xcd_barrier(bb); } }
    for (int ph = (lo > 1 ? lo : 1); ph < hi; ++ph) {
        { int bx_ = blockIdx.x; unsigned char* ws_ = args.ws; float* out_ = args.out; asm volatile("" : "+s"(bx_), "+s"(ws_), "+s"(out_));
          F.ws = ws_; F.out = out_; F.bx = bx_; F.vcu = (F.G % 8 == 0) ? (bx_ % 8) * (F.G / 8) + bx_ / 8 : bx_; }
        if (ph == 1) norm_phase(F, F.xin, 0, 0);
        else {
            const int l = (ph - 2) / 10, k = (ph - 2) % 10;
            const float* mod = (const float*)(F.ws + WS_MOD);
            if ((k == 0 || k == 7) && EN_G1) {
                const int f = (k == 7);
                pg8::Gemm g{(const pg8::bf16_t*)(F.ws + WS_H), (const pg8::bf16_t*)(F.ws + WS_WGU) + (size_t)(l * 2 + f) * NGU * DM, M, NGU, DM};
                pg8::StaticOrder S; S.init(M, NGU, F.G, F.bx);
                pg8::EpiSwiglu E{(pg8::bf16_t*)(F.ws + WS_ACT), DFF};
                pg8::gemm_phase<pg8::EpiSwiglu, pg8::StaticOrder, true, PG8_SP2>(F.lds + RING_OFF, g, S, E);
            } else if ((k == 1 || k == 8) && EN_G2) {
                pg8::Gemm g{(const pg8::bf16_t*)(F.ws + WS_ACT), (const pg8::bf16_t*)(F.ws + WS_WDN) + (size_t)(l * 2 + (k == 8)) * DM * DFF, M, DM, DFF};
                pg8::StaticOrder S; S.init(M, DM, F.G, F.bx);
                pg8::EpiResid E{(l == 0 && k == 1) ? F.xin : (const float*)F.out, F.out, mod + (size_t)(l * BATCH) * NMODV + (k == 1 ? 2 : 8) * DM, NMODV, 0.5f};
                pg8::gemm_phase<pg8::EpiResid, pg8::StaticOrder, true, PG8_SP2>(F.lds + RING_OFF, g, S, E);
            } else if (k == 5 && EN_G2) {
                pg8::Gemm g{(const pg8::bf16_t*)(F.ws + WS_Y), (const pg8::bf16_t*)(F.ws + WS_WOUT) + (size_t)l * DM * DM, M, DM, DM};
                pg8::StaticOrder S; S.init(M, DM, F.G, F.bx);
                pg8::EpiResid E{(const float*)F.out, F.out, mod + (size_t)(l * BATCH) * NMODV + 5 * DM, NMODV, 1.0f};
                pg8::gemm_phase<pg8::EpiResid, pg8::StaticOrder, true, PG8_SP2>(F.lds + RING_OFF, g, S, E);
            } else if (k == 3 && EN_G3) {
                pg8::Gemm g{(const pg8::bf16_t*)(F.ws + WS_H), (const pg8::bf16_t*)(F.ws + WS_WIN) + (size_t)l * NIN * DM, M, NIN, DM};
                pg8::StaticOrder S; S.init(M, NIN, F.G, F.bx);
                pg8::EpiBf16Plain E{(pg8::bf16_t*)(F.ws + WS_PROJ), NIN};
                pg8::gemm_phase<pg8::EpiBf16Plain, pg8::StaticOrder, true, PG8_SP2>(F.lds + RING_OFF, g, S, E);
            } else if (k == 4 && EN_MIX) {
                mixp::mix_phase(F, l);
            } else if (k == 2) norm_phase(F, F.out, l, 1);
            else if (k == 6) norm_phase(F, F.out, l, 2);
            else if (k == 9) {
                if (l + 1 < DEPTH) norm_phase(F, F.out, l + 1, 0);
                else { bool poison = __hip_atomic_load(F.ctl + CW_TMO, RLX_AGENT) != 0u;
                    if (!MK_PER_PHASE) poison |= __hip_atomic_load((gu32*)((const unsigned*)(F.ctl + CW_BAR) + XB_TMO), RLX_AGENT) != 0u;
                    final_phase(F, poison); }
            }
        }
        if (ph + 1 < hi) { XcdBarrier bb = bar; asm volatile("" : "+s"(bb.bar)); xcd_barrier(bb); }
    }
}

extern "C" void kernel_launch(void* const* d_in, const int* in_sizes, int n_in, void* d_out, int out_size, void* d_ws, size_t ws_size, hipStream_t stream) {
    static int grid = 0;
    if (grid == 0) {
        if (n_in != N_IN || in_sizes[0] != M * DM || out_size != M * DM || ws_size < WS_END) { fprintf(stderr, "kernel_launch: unexpected shapes: n_in %d in0 %d out %d ws %zu; nothing launched\n", n_in, n_in > 0 ? in_sizes[0] : -1, out_size, ws_size); grid = -1; return; }
        int dev = 0, cus = 0, per_cu = 0;
        if (hipGetDevice(&dev) != hipSuccess || hipDeviceGetAttribute(&cus, hipDeviceAttributeMultiprocessorCount, dev) != hipSuccess) { fprintf(stderr, "kernel_launch: device query failed\n"); grid = -1; return; }
        if (hipFuncSetAttribute((const void*)trunk_fwd, hipFuncAttributeMaxDynamicSharedMemorySize, LDS_BYTES) != hipSuccess) { fprintf(stderr, "kernel_launch: hipFuncSetAttribute failed\n"); grid = -1; return; }
        if (hipOccupancyMaxActiveBlocksPerMultiprocessor(&per_cu, (const void*)trunk_fwd, NWAVES * 64, LDS_BYTES) != hipSuccess || per_cu < 1) { fprintf(stderr, "kernel_launch: occupancy query reports %d workgroups per CU\n", per_cu); (void)hipGetLastError(); grid = -1; return; }
        grid = cus;
    }
    if (grid < 0) return;
    if (hipMemsetAsync((char*)d_ws + WS_CTL, 0, CTL_ZERO_BYTES, stream) != hipSuccess) { fprintf(stderr, "kernel_launch: memset failed\n"); return; }
    Args a{};
    for (int i = 0; i < N_IN; ++i) a.in[i] = (const float*)d_in[i];
    a.out = (float*)d_out; a.ws = (unsigned char*)d_ws;
#if MK_PER_PHASE
    for (int p = 0; p < NPHASE; ++p) { a.ph_lo = p; a.ph_hi = p + 1; a.li = p; hipLaunchKernelGGL(trunk_fwd, dim3(grid), dim3(NWAVES * 64), LDS_BYTES, stream, a); }
#else
    a.ph_lo = 0; a.ph_hi = NPHASE; a.li = 0;
    hipLaunchKernelGGL(trunk_fwd, dim3(grid), dim3(NWAVES * 64), LDS_BYTES, stream, a);
#endif
    const hipError_t le = hipPeekAtLastError();
    if (le != hipSuccess) fprintf(stderr, "kernel_launch: launch failed: %s\n", hipGetErrorName(le));
}
```

```cpp
#include <hip/hip_runtime.h>
#include <hip/hip_bf16.h>
#include <cstdio>
#include <cstdint>
#include <cmath>
namespace pg8 {
#define PG8_LAS __attribute__((address_space(3)))
typedef unsigned short bf16_t;
typedef short bf16x8 __attribute__((ext_vector_type(8)));
typedef float f32x4 __attribute__((ext_vector_type(4)));
typedef unsigned u32x4 __attribute__((ext_vector_type(4)));
constexpr int BM = 256, BK = 64, HALF = 128, HTB = HALF * BK * 2  , STAGE_BYTES = 8 * HTB, NXCD = 8, WGM = 8;

__host__ __device__ __forceinline__ int lds_byte(int r, int c) { const int st = (r >> 4) * 2 + (c >> 5), rr = r & 15, cc = c & 31, ob = rr * 64 + cc * 2; return st * 1024 + (ob ^ (((ob >> 9) & 1) << 5)); }
__host__ __device__ __forceinline__ void stage_rc(int b, int& R, int& C) { const int st = b / 1024, sb = b % 1024, swz = sb ^ (((sb >> 9) & 1) << 5); R = (st >> 1) * 16 + swz / 64; C = (st & 1) * 32 + (swz % 64) / 2; }
__host__ __device__ __forceinline__ int perm32(int rho) { const int n = rho >> 4, i = rho & 15; return 8 * (i >> 2) + 4 * n + (i & 3); }

struct Unit { int pm, pn; };
struct Gemm { const bf16_t* A; const bf16_t* Bt; int M, N, K; };

struct StaticOrder {
    int nM, nN, nwg, G, c;
    __host__ __device__ void init(int M, int N, int G_, int c_) { nM = M / BM; nN = N / BM; nwg = nM * nN; G = G_; c = c_; }
    __host__ __device__ bool next(int i, Unit& u) const {
        const long L = (long)i * G + c; if (L >= nwg) return false;
        int wgid = (int)L; { const int q = nwg / NXCD, r = nwg % NXCD, xcd = wgid % NXCD, off = wgid / NXCD; wgid = (xcd < r ? xcd * (q + 1) : r * (q + 1) + (xcd - r) * q) + off; }
        const int nig = WGM * nN, gid = wgid / nig, fm = gid * WGM, gsz = (nM - fm) < WGM ? (nM - fm) : WGM;
        u.pm = fm + ((wgid % nig) % gsz); u.pn = (wgid % nig) / gsz; return true;
    }
    __device__ __forceinline__ void a_ready(const Unit&) const {}
    __device__ __forceinline__ void done(const Unit&) const {}
};

__device__ __forceinline__ unsigned cvt_pk_bf16(float lo, float hi) { unsigned r; asm volatile("v_cvt_pk_bf16_f32 %0, %1, %2" : "=v"(r) : "v"(lo), "v"(hi)); return r; }
typedef float f32x2 __attribute__((ext_vector_type(2)));
typedef __bf16 bf16x2_t __attribute__((ext_vector_type(2)));
__device__ __forceinline__ unsigned cvtpk(float lo, float hi) { f32x2 v = {lo, hi}; bf16x2_t b = __builtin_convertvector(v, bf16x2_t); return __builtin_bit_cast(unsigned, b); }
__device__ __forceinline__ float fast_sigmoid(float x) { return __builtin_amdgcn_rcpf(1.0f + __expf(-x)); }
struct EpiBf16Plain {
    static constexpr bool PERM = true, AFTER_DRAIN = false;
    bf16_t* O; int ldc;
    __device__ __forceinline__ void operator()(const f32x4 (&acc)[2][2][4][2], const Unit& u, int wr, int wc, int fr, int fq) const {
        const int row0 = u.pm * BM + wr * 64 + fr, col0 = u.pn * BM + wc * 32 + 8 * fq;
#pragma unroll
        for (int ai = 0; ai < 2; ++ai)
#pragma unroll
            for (int m = 0; m < 4; ++m) { bf16_t* rowp = O + (size_t)(row0 + ai * HALF + m * 16) * ldc + col0;
#pragma unroll
                for (int bj = 0; bj < 2; ++bj) { const f32x4 v0 = acc[ai][bj][m][0], v1 = acc[ai][bj][m][1];
                    u32x4 w; w.x = cvtpk(v0[0], v0[1]); w.y = cvtpk(v0[2], v0[3]); w.z = cvtpk(v1[0], v1[1]); w.w = cvtpk(v1[2], v1[3]);
                    *(u32x4*)(rowp + bj * HALF) = w; } }
    }
};
struct EpiSwiglu {
    static constexpr bool PERM = true, AFTER_DRAIN = false;
    bf16_t* O; int ldc;
    __device__ __forceinline__ void operator()(const f32x4 (&acc)[2][2][4][2], const Unit& u, int wr, int wc, int fr, int fq) const {
        const int row0 = u.pm * BM + wr * 64 + fr, col0 = u.pn * HALF + wc * 32 + 8 * fq;
#pragma unroll
        for (int ai = 0; ai < 2; ++ai)
#pragma unroll
            for (int m = 0; m < 4; ++m) { bf16_t* rowp = O + (size_t)(row0 + ai * HALF + m * 16) * ldc + col0;
                float a[8];
#pragma unroll
                for (int n = 0; n < 2; ++n)
#pragma unroll
                    for (int i = 0; i < 4; ++i) { const float g = acc[ai][0][m][n][i], uu = acc[ai][1][m][n][i]; a[4 * n + i] = g * fast_sigmoid(g) * uu; }
                u32x4 w; w.x = cvtpk(a[0], a[1]); w.y = cvtpk(a[2], a[3]); w.z = cvtpk(a[4], a[5]); w.w = cvtpk(a[6], a[7]);
                *(u32x4*)rowp = w; }
    }
};
struct EpiResid {
    static constexpr bool PERM = false, AFTER_DRAIN = false;
    const float* base; float* out; const float* gate; int gstride; float coef;
    __device__ __forceinline__ void operator()(const f32x4 (&acc)[2][2][4][2], const Unit& u, int wr, int wc, int fr, int fq) const {
        const int row0 = u.pm * BM + wr * 64 + fr, col0 = u.pn * BM + wc * 32 + 4 * fq;
        const float* gb = gate + (size_t)(u.pm >> 5) * gstride;
        f32x4 gv[2][2];
#pragma unroll
        for (int bj = 0; bj < 2; ++bj)
#pragma unroll
            for (int n = 0; n < 2; ++n) gv[bj][n] = *(const f32x4*)(gb + col0 + bj * HALF + n * 16) * coef;
#pragma unroll
        for (int ai = 0; ai < 2; ++ai)
#pragma unroll
            for (int m = 0; m < 4; ++m) { const size_t off = (size_t)(row0 + ai * HALF + m * 16) * 1024 + col0;
#pragma unroll
                for (int bj = 0; bj < 2; ++bj)
#pragma unroll
                    for (int n = 0; n < 2; ++n) { const f32x4 bs = *(const f32x4*)(base + off + bj * HALF + n * 16);
                        *(f32x4*)(out + off + bj * HALF + n * 16) = bs + gv[bj][n] * acc[ai][bj][m][n]; } }
    }
};

template <class Epi, class Sched, bool ALIGN_EPI = false, bool SP2 = false>
__device__ __forceinline__ void gemm_phase(PG8_LAS unsigned char* lds, const Gemm g, const Sched& S, const Epi& E) {
    int tid_ = threadIdx.x; asm volatile("" : "+v"(tid_));
    const int tid = tid_, wid = __builtin_amdgcn_readfirstlane(tid >> 6), lane = tid & 63, wr = wid >> 2, wc = wid & 3, fr = lane & 15, fq = lane >> 4;
    const int K = g.K, nt = K / BK;
    unsigned voffA[2], voffB[2];
#pragma unroll
    for (int i = 0; i < 2; ++i) { int R, C; stage_rc(tid * 16 + i * 8192, R, C); const int Rb = Epi::PERM ? ((R & ~31) + perm32(R & 31)) : R;
        voffA[i] = (unsigned)(R * K + C) * 2u; voffB[i] = (unsigned)(Rb * K + C) * 2u; }
    const size_t kstep = (size_t)(BK * 2);
    const size_t hstep = (size_t)HALF * K * 2;
    const size_t tstep = 2 * hstep;
    const unsigned ldsw = (unsigned)wid * 1024u;
    const int aoff = lds_byte(wr * 64 + fr, fq * 8), boff = lds_byte(wc * 32 + fr, fq * 8);
#define PG8_SA(b, h) (((b) * 2 + (h)) * HTB)
#define PG8_SB(b, h) ((4 + (b) * 2 + (h)) * HTB)
#define PG8_STAGE(bufoff, gbase, voff) do { _Pragma("unroll") for (int _i = 0; _i < 2; ++_i) \
        __builtin_amdgcn_global_load_lds((const unsigned*)((const char*)(gbase) + (voff)[_i]), (PG8_LAS unsigned*)(lds + (bufoff) + ldsw + _i * 8192), 16, 0, 0); } while (0)
#define PG8_LDA(dst, b, h) do { _Pragma("unroll") for (int m = 0; m < 4; ++m) _Pragma("unroll") for (int k = 0; k < 2; ++k) dst[m][k] = *(const PG8_LAS bf16x8*)(lds + PG8_SA(b, h) + aoff + m * 2048 + k * 1024); } while (0)
#define PG8_LDB(dst, b, h) do { _Pragma("unroll") for (int n = 0; n < 2; ++n) _Pragma("unroll") for (int k = 0; k < 2; ++k) dst[n][k] = *(const PG8_LAS bf16x8*)(lds + PG8_SB(b, h) + boff + n * 2048 + k * 1024); } while (0)
#define PG8_MMA(ai, bj, At, Bt) do { __builtin_amdgcn_s_setprio(1); _Pragma("unroll") for (int m = 0; m < 4; ++m) _Pragma("unroll") for (int n = 0; n < 2; ++n) _Pragma("unroll") for (int k = 0; k < 2; ++k) \
        acc[ai][bj][m][n] = __builtin_amdgcn_mfma_f32_16x16x32_bf16(Bt[n][k], At[m][k], acc[ai][bj][m][n], 0, 0, 0); __builtin_amdgcn_s_setprio(0); } while (0)
#define PG8_WAIT_V(n) asm volatile("s_waitcnt vmcnt(" #n ")" ::: "memory")
#define PG8_WAIT_L(n) asm volatile("s_waitcnt lgkmcnt(" #n ")" ::: "memory")
#define PG8_BAR __builtin_amdgcn_s_barrier()
#define PG8_SCHED __builtin_amdgcn_sched_barrier(0)
    Unit cur, nxt; int ui = 0;
    if (!S.next(0, cur)) return;
    f32x4 acc[2][2][4][2];
#pragma unroll
    for (int a = 0; a < 2; ++a)
#pragma unroll
        for (int b = 0; b < 2; ++b)
#pragma unroll
            for (int m = 0; m < 4; ++m)
#pragma unroll
                for (int n = 0; n < 2; ++n) acc[a][b][m][n] = (f32x4){0.f, 0.f, 0.f, 0.f};
    bf16x8 At[4][2], B0[2][2], B1[2][2];
    const char* cA = (const char*)g.A + (size_t)cur.pm * tstep; const char* cB = (const char*)g.Bt + (size_t)cur.pn * tstep;
    S.a_ready(cur);
    if constexpr (SP2) {
        PG8_STAGE(PG8_SB(0, 0), cB, voffB); PG8_STAGE(PG8_SB(0, 1), cB + hstep, voffB); PG8_STAGE(PG8_SA(0, 0), cA, voffA); PG8_STAGE(PG8_SA(0, 1), cA + hstep, voffA);
        if (wr == 1) PG8_BAR;
        PG8_WAIT_V(2); PG8_BAR;
        PG8_STAGE(PG8_SB(1, 0), cB + kstep, voffB); PG8_STAGE(PG8_SA(1, 0), cA + kstep, voffA); PG8_STAGE(PG8_SB(1, 1), cB + hstep + kstep, voffB);
        PG8_WAIT_V(6); PG8_BAR;
    } else {
        PG8_STAGE(PG8_SB(0, 0), cB, voffB); PG8_STAGE(PG8_SA(0, 0), cA, voffA); PG8_STAGE(PG8_SB(0, 1), cB + hstep, voffB); PG8_STAGE(PG8_SA(0, 1), cA + hstep, voffA);
        if (wr == 1) PG8_BAR;
        PG8_WAIT_V(4); PG8_BAR;
        PG8_STAGE(PG8_SB(1, 0), cB + kstep, voffB); PG8_STAGE(PG8_SA(1, 0), cA + kstep, voffA); PG8_STAGE(PG8_SB(1, 1), cB + hstep + kstep, voffB);
        PG8_WAIT_V(6); PG8_BAR;
    }
    for (;;) {
        const bool has_next = S.next(ui + 1, nxt);
        const char* nA = has_next ? (const char*)g.A + (size_t)nxt.pm * tstep : cA; const char* nB = has_next ? (const char*)g.Bt + (size_t)nxt.pn * tstep : cB;
        for (int t = 0; t < nt; t += 2) {
            const bool last = (t == nt - 2);
            const char* a1 = cA + (size_t)(t + 1) * kstep;
            const char* a2 = last ? nA : cA + (size_t)(t + 2) * kstep; const char* b2 = last ? nB : cB + (size_t)(t + 2) * kstep;
            const char* a3 = a2 + kstep; const char* b3 = b2 + kstep;
            if (last && has_next) S.a_ready(nxt);
            if constexpr (SP2) {
            PG8_LDB(B0, 0, 0); PG8_LDB(B1, 0, 1); PG8_SCHED; PG8_LDA(At, 0, 0); PG8_STAGE(PG8_SA(1, 1), a1 + hstep, voffA);
            PG8_WAIT_V(8); PG8_WAIT_L(0); PG8_BAR; PG8_MMA(0, 0, At, B0); PG8_MMA(0, 1, At, B1); PG8_BAR; PG8_SCHED;
            PG8_LDA(At, 0, 1); PG8_STAGE(PG8_SB(0, 0), b2, voffB); PG8_STAGE(PG8_SB(0, 1), b2 + hstep, voffB); PG8_STAGE(PG8_SA(0, 0), a2, voffA);
            PG8_WAIT_V(8); PG8_WAIT_L(0); PG8_BAR; PG8_MMA(1, 0, At, B0); PG8_MMA(1, 1, At, B1); PG8_BAR; PG8_SCHED;
            PG8_LDB(B0, 1, 0); PG8_LDB(B1, 1, 1); PG8_SCHED; PG8_LDA(At, 1, 0); PG8_STAGE(PG8_SA(0, 1), a2 + hstep, voffA);
            PG8_WAIT_V(8); PG8_WAIT_L(0); PG8_BAR; PG8_MMA(0, 0, At, B0); PG8_MMA(0, 1, At, B1); PG8_BAR; PG8_SCHED;
            PG8_LDA(At, 1, 1); PG8_STAGE(PG8_SB(1, 0), b3, voffB); PG8_STAGE(PG8_SB(1, 1), b3 + hstep, voffB); PG8_STAGE(PG8_SA(1, 0), a3, voffA);
            PG8_WAIT_V(8); PG8_WAIT_L(0); PG8_BAR; PG8_MMA(1, 0, At, B0); PG8_MMA(1, 1, At, B1); PG8_BAR; PG8_SCHED;
            } else {
            PG8_LDB(B0, 0, 0); PG8_SCHED; PG8_LDA(At, 0, 0); PG8_STAGE(PG8_SA(1, 1), a1 + hstep, voffA);
            PG8_WAIT_L(8); PG8_BAR; PG8_WAIT_L(0); PG8_MMA(0, 0, At, B0); PG8_BAR; PG8_SCHED;
            PG8_LDB(B1, 0, 1); PG8_STAGE(PG8_SB(0, 0), b2, voffB);
            PG8_BAR; PG8_WAIT_L(0); PG8_MMA(0, 1, At, B1); PG8_BAR;
            PG8_LDA(At, 0, 1); PG8_STAGE(PG8_SA(0, 0), a2, voffA);
            PG8_BAR; PG8_WAIT_L(0); PG8_MMA(1, 0, At, B0); PG8_BAR; PG8_SCHED;
            PG8_STAGE(PG8_SB(0, 1), b2 + hstep, voffB);
            PG8_WAIT_V(6); PG8_BAR; PG8_MMA(1, 1, At, B1); PG8_BAR;
            PG8_LDB(B0, 1, 0); PG8_SCHED; PG8_LDA(At, 1, 0); PG8_STAGE(PG8_SA(0, 1), a2 + hstep, voffA);
            PG8_WAIT_L(8); PG8_BAR; PG8_WAIT_L(0); PG8_MMA(0, 0, At, B0); PG8_BAR; PG8_SCHED;
            PG8_LDB(B1, 1, 1); PG8_STAGE(PG8_SB(1, 0), b3, voffB);
            PG8_BAR; PG8_WAIT_L(0); PG8_MMA(0, 1, At, B1); PG8_BAR;
            PG8_LDA(At, 1, 1); PG8_STAGE(PG8_SA(1, 0), a3, voffA);
            PG8_BAR; PG8_WAIT_L(0); PG8_MMA(1, 0, At, B0); PG8_BAR; PG8_SCHED;
            PG8_STAGE(PG8_SB(1, 1), b3 + hstep, voffB);
            PG8_WAIT_V(6); PG8_BAR; PG8_MMA(1, 1, At, B1); PG8_BAR;
            }
        }
        if constexpr (ALIGN_EPI) { if (wr == 0) PG8_BAR; }
        if constexpr (!Epi::AFTER_DRAIN) { E(acc, cur, wr, wc, fr, fq); S.done(cur); }
        if (!has_next) break;
#pragma unroll
        for (int a = 0; a < 2; ++a)
#pragma unroll
            for (int b = 0; b < 2; ++b)
#pragma unroll
                for (int m = 0; m < 4; ++m)
#pragma unroll
                    for (int n = 0; n < 2; ++n) acc[a][b][m][n] = (f32x4){0.f, 0.f, 0.f, 0.f};
        cur = nxt; cA = nA; cB = nB; ++ui;
        if constexpr (ALIGN_EPI) { if (wr == 1) PG8_BAR; }
    }
    PG8_WAIT_V(0);
    if constexpr (!ALIGN_EPI) { if (wr == 0) PG8_BAR; }
    PG8_BAR;
    if constexpr (Epi::AFTER_DRAIN) { E.fused(acc, cur, wr, wc, fr, fq, lds, wid, lane); S.done(cur); }
#undef PG8_SA
#undef PG8_SB
#undef PG8_STAGE
#undef PG8_LDA
#undef PG8_LDB
#undef PG8_MMA
#undef PG8_WAIT_V
#undef PG8_WAIT_L
#undef PG8_BAR
#undef PG8_SCHED
}
}

#ifndef PG8_SP2
#define PG8_SP2 true
#endif
#ifndef PG8_ALIGN
#define PG8_ALIGN true
#endif
#define GAS __attribute__((address_space(1)))
#define LAS __attribute__((address_space(3)))
typedef unsigned short bf16;
typedef unsigned v4u __attribute__((ext_vector_type(4)));
typedef float f32x4 __attribute__((ext_vector_type(4)));
typedef short bf16x8 __attribute__((ext_vector_type(8)));
typedef GAS unsigned gu32;
typedef GAS unsigned long long gu64;
#define RLX_AGENT __ATOMIC_RELAXED, __HIP_MEMORY_SCOPE_AGENT
#define LDS_WAIT() asm volatile("s_waitcnt lgkmcnt(0)" ::: "memory")
#define VM_WAIT() asm volatile("s_waitcnt vmcnt(0)" ::: "memory")
__device__ __forceinline__ unsigned long long rt() { return __builtin_amdgcn_s_memrealtime(); }
__device__ __forceinline__ unsigned f2bf(float f) { unsigned u = __builtin_bit_cast(unsigned, f); return (u + 0x7fffu + ((u >> 16) & 1u)) >> 16; }
__device__ __forceinline__ unsigned pk2(float lo, float hi) { return f2bf(lo) | (f2bf(hi) << 16); }

#define XB_TMO      128
#define XB_XCNT(j)  (256  + 64 * (j))
#define XB_XSUB(j)  (1280 + 64 * (j))
#define XB_XGEN(j)  (2304 + 64 * (j))
#define XB_TOP      3328
#define XB_TOPGEN   3392
#define XCD_BAR_WORDS 3456
#define XB_SPIN_CAP (1u << 18)

__device__ __forceinline__ unsigned xb_ld(unsigned* p)              { return __hip_atomic_load(p, __ATOMIC_RELAXED, __HIP_MEMORY_SCOPE_AGENT); }
__device__ __forceinline__ unsigned xb_add(unsigned* p, unsigned v) { return __hip_atomic_fetch_add(p, v, __ATOMIC_RELAXED, __HIP_MEMORY_SCOPE_AGENT); }
__device__ __forceinline__ unsigned xb_xcc_id() { return (unsigned)__builtin_amdgcn_s_getreg((3 << 11) | 20) & 0xFu; }
#define XB_SPIN(cond, bar) do { unsigned _sp = 0; while (cond) { __builtin_amdgcn_s_sleep(1); \
    if ((++_sp & 255u) == 0u) { if (xb_ld(&(bar)[XB_TMO])) break; if (_sp > XB_SPIN_CAP) { atomicAdd(&(bar)[XB_TMO], 1u); break; } } } } while (0)

struct XcdBarrier {
    unsigned* bar; unsigned x;
    volatile LAS unsigned* st;
};

__device__ __forceinline__ XcdBarrier xcd_barrier_post(unsigned* bar, volatile LAS unsigned* st) {
    XcdBarrier b; b.bar = bar; b.x = xb_xcc_id(); b.st = st;
    if (threadIdx.x == 0) (void)xb_add(&bar[XB_XCNT(b.x)], 1u);
    return b;
}
__device__ __forceinline__ void xcd_barrier_complete(unsigned* bar, unsigned x, unsigned& nloc, unsigned& nx) {
    const unsigned G = gridDim.x * gridDim.y * gridDim.z;
    unsigned sum, cnt, mine, sp = 0u;
    for (;;) {
        sum = 0u; cnt = 0u; mine = 0u;
#pragma unroll
        for (unsigned j = 0; j < 16; ++j) { const unsigned c = xb_ld(&bar[XB_XCNT(j)]); sum += c; cnt += (c > 0u) ? 1u : 0u; mine = (j == x) ? c : mine; }
        if (sum == G) break;
        __builtin_amdgcn_s_sleep(1);
        if ((++sp & 255u) == 0u) { if (xb_ld(&bar[XB_TMO])) break; if (sp > XB_SPIN_CAP) { atomicAdd(&bar[XB_TMO], 1u); break; } }
    }
    nloc = mine > 0u ? mine : 1u; nx = cnt > 0u ? cnt : 1u;
}

__device__ __forceinline__ void xcd_barrier(const XcdBarrier& b) {
    asm volatile("s_waitcnt vmcnt(0)" ::: "memory");
    __syncthreads();
    if (threadIdx.x == 0) {
        unsigned* bar = b.bar;
        __builtin_amdgcn_s_waitcnt(0);
        unsigned nloc = b.st[0], nx = b.st[1];
        if (nloc == 0u) { xcd_barrier_complete(bar, b.x, nloc, nx); b.st[0] = nloc; b.st[1] = nx; }
        const unsigned old = xb_add(&bar[XB_XSUB(b.x)], 1u);
        const unsigned gen = old / nloc;
        if (old + 1u == (gen + 1u) * nloc) {
            __builtin_amdgcn_fence(__ATOMIC_RELEASE, "agent");
            asm volatile("s_waitcnt vmcnt(0)" ::: "memory");
            const unsigned og = xb_add(&bar[XB_TOP], 1u);
            const unsigned tg = og / nx;
            if (og + 1u == (tg + 1u) * nx) xb_add(&bar[XB_TOPGEN], 1u);
            else XB_SPIN(xb_ld(&bar[XB_TOPGEN]) == tg, bar);
            __builtin_amdgcn_fence(__ATOMIC_ACQUIRE, "agent");
            xb_add(&bar[XB_XGEN(b.x)], 1u);
            asm volatile("s_waitcnt vmcnt(0)" ::: "memory");
        } else {
            XB_SPIN(xb_ld(&bar[XB_XGEN(b.x)]) == gen, bar);
            __builtin_amdgcn_fence(__ATOMIC_ACQUIRE, "agent");
            asm volatile("s_waitcnt vmcnt(0)" ::: "memory");
        }
    }
    __syncthreads();
}

#ifndef EN_P0
#define EN_P0 1
#endif
#ifndef EN_G1
#define EN_G1 1
#endif
#ifndef EN_G2
#define EN_G2 1
#endif
#ifndef EN_G3
#define EN_G3 1
#endif
#ifndef EN_MIX
#define EN_MIX 1
#endif
#ifndef REP_MASK
#define REP_MASK 0
#endif
#ifndef MK_PER_PHASE
#define MK_PER_PHASE 0
#endif
constexpr int NWAVES = 8;
constexpr int BATCH = 2, SEQ = 8192, DM = 1024, DEPTH = 2, DFF = 2816, NGU = 2 * DFF, NIN = 2048, NMODV = 9 * DM;
constexpr int M = BATCH * SEQ;
constexpr float RMS_EPS = 1e-6f;
constexpr int NPHASE = 2 + 10 * DEPTH;

enum { IN_X = 0, IN_C, IN_WMOD, IN_BMOD, IN_GNORM, IN_GU1, IN_DN1, IN_GU2, IN_DN2, IN_WIN, IN_WOUT, IN_SINKS, IN_LCW, IN_LCB, IN_GAW, IN_GAB, IN_GXW, IN_GXB, IN_LAM, IN_SCW, IN_GFIN, N_IN };

constexpr size_t MiB = 1u << 20;
constexpr size_t WS_CTL = 0, CTL_ZERO_BYTES = 2 * MiB;
constexpr size_t WS_GRAN = 1 * MiB;
constexpr size_t WS_MOD = 2 * MiB;
constexpr size_t WS_PAR = 2 * MiB + 512 * 1024;
constexpr int P_GNORM = 0, P_GFIN = 6144, P_SINKS = 7168, P_LCW = 7184, P_LCB = 9232, P_GAB = 9744, P_GXB = 10256, P_SP = 10768, P_SCW = 11280, P_END = 12816;
constexpr size_t WS_GWT = WS_PAR + 64 * 1024;
static_assert((size_t)P_END * 4 <= 64 * 1024 && WS_GWT + 2 * (size_t)DEPTH * 4 * 4096 * 2 <= 3 * MiB, "ws map (params)");
constexpr size_t WS_WGU = 3 * MiB;
constexpr size_t WS_WDN = 47 * MiB;
constexpr size_t WS_WIN = 69 * MiB;
constexpr size_t WS_WOUT = 77 * MiB;
constexpr size_t WS_H = 81 * MiB;
constexpr size_t WS_ACT = 113 * MiB;
constexpr size_t WS_PROJ = 113 * MiB;
constexpr size_t WS_Y = 177 * MiB;
constexpr size_t WS_END = 209 * MiB;
static_assert(WS_WGU + 4 * (size_t)NGU * DM * 2 <= WS_WDN && WS_WDN + 4 * (size_t)DM * DFF * 2 <= WS_WIN && WS_WIN + 2 * (size_t)NIN * DM * 2 <= WS_WOUT && WS_WOUT + 2 * (size_t)DM * DM * 2 <= WS_H, "ws map (weights)");
static_assert(WS_H + (size_t)M * DM * 2 <= WS_ACT && WS_ACT + (size_t)M * DFF * 2 <= WS_END && WS_PROJ + (size_t)M * NIN * 2 <= WS_Y && WS_Y + (size_t)M * DM * 2 <= WS_END, "ws map (activations)");
constexpr int CW_TMO = 0, CW_CODE = 1, CW_BAR = 4096;

constexpr int RING_OFF = 0, RING_BYTES = 131072;
constexpr int LDS_BYTES = 147456;
constexpr int LDSCTL_OFF = LDS_BYTES - 512, MISC_OFF = LDSCTL_OFF + 320;

typedef unsigned u32x4 __attribute__((ext_vector_type(4)));
typedef float f32x16 __attribute__((ext_vector_type(16)));
#define DI __device__ __forceinline__
#define MFMA32(a, b, c) __builtin_amdgcn_mfma_f32_32x32x16_bf16((a), (b), (c), 0, 0, 0)

struct Frame {
    LAS unsigned char* lds;
    volatile LAS unsigned* MISC;
    gu32* ctl;
    int vcu, G, bx;
    float* out; unsigned char* ws; const float* xin;
};
struct Args { const float* in[N_IN]; float* out; unsigned char* ws; int ph_lo, ph_hi, li, pad; };
#define FRESH_IDS(F) int tid = threadIdx.x; asm volatile("" : "+v"(tid)); const int lane = tid & 63, w = __builtin_amdgcn_readfirstlane(tid >> 6); (void)lane; (void)w
#define PARF(F) ((const float*)((F).ws + WS_PAR))
DI float bf2f(short v) { return __builtin_bit_cast(float, (unsigned)(unsigned short)v << 16); }
DI unsigned cvtpk2(float lo, float hi) { return pg8::cvtpk(lo, hi); }
DI float lane_read(float v, int src_lane) { return __builtin_bit_cast(float, __builtin_amdgcn_ds_bpermute(src_lane << 2, __builtin_bit_cast(int, v))); }
DI float wave_sum(float v, int lane) {
#pragma unroll
    for (int o = 1; o < 64; o <<= 1) v += lane_read(v, lane ^ o);
    return v;
}
DI void set_tmo(Frame& F, unsigned code) {
    unsigned expect = 0u; __hip_atomic_compare_exchange_strong((unsigned*)(F.ctl + CW_CODE), &expect, code, __ATOMIC_RELAXED, __ATOMIC_RELAXED, __HIP_MEMORY_SCOPE_AGENT);
    __hip_atomic_store(F.ctl + CW_TMO, 1u, RLX_AGENT);
}

DI void tr_item(const float* W, int K, int N, bf16* WT, bool gu, LAS float* scr, int item, int lane) {
    const int nblk = N / 32, kb = item / nblk, nb = item % nblk, k0 = 64 * kb, n0 = 32 * nb;
    int c0 = n0; if (gu) { const int pn = n0 >> 8, bj = (n0 >> 7) & 1, j0 = n0 & 127; c0 = bj * DFF + 128 * pn + j0; }
#pragma unroll 8
    for (int i = 0; i < 32; ++i) { const int kk = 2 * i + (lane >> 5); scr[kk * 33 + (lane & 31)] = W[(size_t)(k0 + kk) * N + c0 + (lane & 31)]; }
    LDS_WAIT(); asm volatile("" ::: "memory");
    const int c = lane & 7;
#pragma unroll
    for (int j = 0; j < 4; ++j) { const int n = (lane >> 3) + 8 * j; const LAS float* s = scr + (8 * c) * 33 + n;
        v4u o; o.x = pk2(s[0 * 33], s[1 * 33]); o.y = pk2(s[2 * 33], s[3 * 33]); o.z = pk2(s[4 * 33], s[5 * 33]); o.w = pk2(s[6 * 33], s[7 * 33]);
        *(GAS v4u*)(WT + (size_t)(n0 + n) * K + k0 + 8 * c) = o; }
    LDS_WAIT(); asm volatile("" ::: "memory");
}
DI void p0_phase(Frame& F, const Args& A) {
    FRESH_IDS(F);
    for (int it = F.vcu; it < DEPTH * 72; it += F.G) {
        LAS float* SC = (LAS float*)(F.lds); LAS float* PART = (LAS float*)(F.lds + 8192);
        for (int i = tid; i < BATCH * DM; i += NWAVES * 64) { const float cv = A.in[IN_C][i]; SC[i] = cv / (1.0f + __expf(-cv)); }
        __syncthreads();
        const int l = it / 72, cg = it % 72;
        const float* W = A.in[IN_WMOD] + (size_t)l * DM * NMODV + 128 * cg + 2 * lane;
        float a00 = 0.f, a01 = 0.f, a10 = 0.f, a11 = 0.f;
        const int k0 = w * 128;
#pragma unroll 8
        for (int k = 0; k < 128; ++k) { const float2 w = *(const float2*)(W + (size_t)(k0 + k) * NMODV); const float s0 = SC[k0 + k], s1 = SC[DM + k0 + k];
            a00 += s0 * w.x; a01 += s0 * w.y; a10 += s1 * w.x; a11 += s1 * w.y; }
        PART[(w * 2 + 0) * 128 + 2 * lane] = a00; PART[(w * 2 + 0) * 128 + 2 * lane + 1] = a01;
        PART[(w * 2 + 1) * 128 + 2 * lane] = a10; PART[(w * 2 + 1) * 128 + 2 * lane + 1] = a11;
        __syncthreads();
        if (tid < 256) { const int b = tid >> 7, col = tid & 127; float s = 0.f;
#pragma unroll
            for (int w = 0; w < 8; ++w) s += PART[(w * 2 + b) * 128 + col];
            float* mod = (float*)(F.ws + WS_MOD);
            mod[(size_t)(l * BATCH + b) * NMODV + 128 * cg + col] = s + A.in[IN_BMOD][(size_t)l * NMODV + 128 * cg + col]; }
        __syncthreads();
    }
    {
        float* par = (float*)(F.ws + WS_PAR); const int gt = F.vcu * (NWAVES * 64) + tid, NGT = F.G * NWAVES * 64;
        for (int i = gt; i < DEPTH * 3 * DM; i += NGT) par[P_GNORM + i] = A.in[IN_GNORM][i];
        for (int i = gt; i < DM; i += NGT) par[P_GFIN + i] = A.in[IN_GFIN][i];
        for (int i = gt; i < DEPTH * 8; i += NGT) par[P_SINKS + i] = A.in[IN_SINKS][i];
        for (int i = gt; i < DEPTH * 4 * 256; i += NGT) par[P_LCW + i] = A.in[IN_LCW][i];
        for (int i = gt; i < DEPTH * 256; i += NGT) { par[P_LCB + i] = A.in[IN_LCB][i]; par[P_GAB + i] = A.in[IN_GAB][i]; par[P_GXB + i] = A.in[IN_GXB][i]; par[P_SP + i] = log1pf(expf(-A.in[IN_LAM][i])); }
        for (int i = gt; i < DEPTH * 3 * 256; i += NGT) par[P_SCW + i] = A.in[IN_SCW][i];
        { bf16* gwt = (bf16*)(F.ws + WS_GWT);
          for (int i = gt; i < 2 * DEPTH * 4 * 4096; i += NGT) { const int gate = i / (DEPTH * 4 * 4096), rem = i % (DEPTH * 4 * 4096), hd = rem >> 12, e = (rem >> 6) & 63, d = rem & 63;
              gwt[i] = (bf16)f2bf((gate ? A.in[IN_GXW] : A.in[IN_GAW])[hd * 4096 + d * 64 + e]); } }
    }
    LAS float* scr = (LAS float*)(F.lds + RING_OFF + w * 16384);
    const int gw = F.vcu * NWAVES + w, NGW = F.G * NWAVES;
    constexpr int I_GU = (DM / 64) * (NGU / 32), I_DN = (DFF / 64) * (DM / 32), I_IN = (DM / 64) * (NIN / 32), I_OUT = (DM / 64) * (DM / 32);
    constexpr int NITEMS = 4 * I_GU + 4 * I_DN + 2 * I_IN + 2 * I_OUT;
    for (int it = gw; it < NITEMS; it += NGW) {
        int r = it;
        if (r < 4 * I_GU) { const int m = r / I_GU, i = r % I_GU, l = m >> 1, f = m & 1;
            tr_item((f ? A.in[IN_GU2] : A.in[IN_GU1]) + (size_t)l * DM * NGU, DM, NGU, (bf16*)(F.ws + WS_WGU) + (size_t)m * NGU * DM, true, scr, i, lane); continue; }
        r -= 4 * I_GU;
        if (r < 4 * I_DN) { const int m = r / I_DN, i = r % I_DN, l = m >> 1, f = m & 1;
            tr_item((f ? A.in[IN_DN2] : A.in[IN_DN1]) + (size_t)l * DFF * DM, DFF, DM, (bf16*)(F.ws + WS_WDN) + (size_t)m * DM * DFF, false, scr, i, lane); continue; }
        r -= 4 * I_DN;
        if (r < 2 * I_IN) { const int l = r / I_IN, i = r % I_IN;
            tr_item(A.in[IN_WIN] + (size_t)l * DM * NIN, DM, NIN, (bf16*)(F.ws + WS_WIN) + (size_t)l * NIN * DM, false, scr, i, lane); continue; }
        r -= 2 * I_IN;
        { const int l = r / I_OUT, i = r % I_OUT;
            tr_item(A.in[IN_WOUT] + (size_t)l * DM * DM, DM, DM, (bf16*)(F.ws + WS_WOUT) + (size_t)l * DM * DM, false, scr, i, lane); }
    }
}

DI void norm_phase(Frame& F, const float* src, int l, int sub) {
    FRESH_IDS(F);
    const int gw = F.vcu * NWAVES + w, NGW = F.G * NWAVES;
    const float* mod = (const float*)(F.ws + WS_MOD);
    bf16* H = (bf16*)(F.ws + WS_H);
    const float* gn = PARF(F) + P_GNORM + (l * 3 + sub) * DM;
    for (int m = gw; m < M; m += NGW) {
        const int b = m >> 13;
        const GAS f32x4* xr = (const GAS f32x4*)(src + (size_t)m * DM) + lane;
        const float* shp = mod + (size_t)(l * BATCH + b) * NMODV + (3 * sub) * DM; const float* scp = shp + DM;
        f32x4 v[4]; float s = 0.f;
#pragma unroll
        for (int j = 0; j < 4; ++j) { v[j] = xr[64 * j]; s += (v[j].x * v[j].x + v[j].y * v[j].y) + (v[j].z * v[j].z + v[j].w * v[j].w); }
        const float rstd = 1.0f / sqrtf(wave_sum(s, lane) * (1.f / DM) + RMS_EPS);
        GAS unsigned long long* o8 = (GAS unsigned long long*)(H + (size_t)m * DM) + lane;
#pragma unroll
        for (int j = 0; j < 4; ++j) { const int k = 4 * lane + 256 * j;
            const f32x4 g4 = *(const f32x4*)(gn + k), sc4 = *(const f32x4*)(scp + k), sh4 = *(const f32x4*)(shp + k);
            const f32x4 o = v[j] * rstd * g4 * (sc4 + 1.0f) + sh4;
            o8[64 * j] = (unsigned long long)cvtpk2(o.x, o.y) | ((unsigned long long)cvtpk2(o.z, o.w) << 32); }
    }
}
DI void final_phase(Frame& F, bool poison) {
    FRESH_IDS(F);
    const int gw = F.vcu * NWAVES + w, NGW = F.G * NWAVES;
    const float* gn = PARF(F) + P_GFIN; const float qnan = __builtin_nanf("");
    for (int m = gw; m < M; m += NGW) {
        GAS f32x4* xr = (GAS f32x4*)(F.out + (size_t)m * DM) + lane;
        f32x4 v[4]; float s = 0.f;
#pragma unroll
        for (int j = 0; j < 4; ++j) { v[j] = xr[64 * j]; s += (v[j].x * v[j].x + v[j].y * v[j].y) + (v[j].z * v[j].z + v[j].w * v[j].w); }
        const float rstd = 1.0f / sqrtf(wave_sum(s, lane) * (1.f / DM) + RMS_EPS);
#pragma unroll
        for (int j = 0; j < 4; ++j) { const f32x4 g4 = *(const f32x4*)(gn + 4 * lane + 256 * j); f32x4 o = v[j] * rstd * g4; if (poison) o = (f32x4){qnan, qnan, qnan, qnan}; xr[64 * j] = o; }
    }
}

namespace mixp {
constexpr int KROW = 144;
constexpr int L_K = 0, L_V = 256 * KROW, L_OST = 2 * 256 * KROW, OST_WAVE = 32 * KROW;
constexpr int XROW = 132;
constexpr int L_XC = 0, L_A = 128 * XROW * 4, L_SEG = 2 * L_A, L_HIN = L_SEG + 4096, L_GP = L_HIN + 512, L_END = L_GP + 4096;
static_assert(L_END <= LDSCTL_OFF && L_OST + 8 * OST_WAVE <= L_HIN, "mixer LDS map");
typedef short v4i16_t __attribute__((ext_vector_type(4)));
DI int crow(int i, int h) { return (i & 3) + 8 * (i >> 2) + 4 * h; }
DI float gelu_tanh(float x) { const float z = 0.7978845608028654f * (x + 0.044715f * x * x * x); const float t = 1.0f - 2.0f * __builtin_amdgcn_rcpf(1.0f + __expf(2.0f * z)); return 0.5f * x * (1.0f + t); }
DI float fsig(float x) { return __builtin_amdgcn_rcpf(1.0f + __expf(-x)); }

template <bool PASS2>
DI void lru_unit(Frame& F, int l, int b, int blk, int kvh, const bf16* PROJ, bf16* Y, gu64* gran) {
    FRESH_IDS(F);
    LAS unsigned char* lds = F.lds;
    LAS float* XC = (LAS float*)(lds + L_XC); LAS float* AL = (LAS float*)(lds + L_A); LAS float* SEG = (LAS float*)(lds + L_SEG);
    const long rowbase = (long)b * SEQ + blk * 128;
    const int ch0 = 128 * kvh;
    const float* par = PARF(F);
    {
        const float* cw = par + P_LCW + l * 4 * 256 + ch0; const float* cb = par + P_LCB + l * 256 + ch0;
#pragma unroll
        for (int it = 0; it < 4; ++it) {
            const int idx = tid + 512 * it, t = idx >> 4, c8 = (idx & 15) * 8;
            float acc[8];
            { const f32x4 b0 = *(const GAS f32x4*)(cb + c8), b1 = *(const GAS f32x4*)(cb + c8 + 4); acc[0] = b0.x; acc[1] = b0.y; acc[2] = b0.z; acc[3] = b0.w; acc[4] = b1.x; acc[5] = b1.y; acc[6] = b1.z; acc[7] = b1.w; }
#pragma unroll
            for (int k = 0; k < 4; ++k) { const int tt = t - 3 + k;
                if (blk > 0 || tt >= 0) {
                    const bf16x8 v = *(const GAS bf16x8*)(PROJ + (rowbase + tt) * NIN + 768 + ch0 + c8);
                    const f32x4 w0 = *(const GAS f32x4*)(cw + k * 256 + c8), w1 = *(const GAS f32x4*)(cw + k * 256 + c8 + 4);
                    acc[0] += w0.x * bf2f(v[0]); acc[1] += w0.y * bf2f(v[1]); acc[2] += w0.z * bf2f(v[2]); acc[3] += w0.w * bf2f(v[3]);
                    acc[4] += w1.x * bf2f(v[4]); acc[5] += w1.y * bf2f(v[5]); acc[6] += w1.z * bf2f(v[6]); acc[7] += w1.w * bf2f(v[7]); } }
            *(LAS f32x4*)(XC + t * XROW + c8) = (f32x4){acc[0], acc[1], acc[2], acc[3]};
            *(LAS f32x4*)(XC + t * XROW + c8 + 4) = (f32x4){acc[4], acc[5], acc[6], acc[7]};
        }
    }
    {
        const int tt = w & 3, hl = w >> 2, r = lane & 31, h = lane >> 5;
        const bf16* gwa = (const bf16*)(F.ws + WS_GWT) + (size_t)(l * 4 + 2 * kvh + hl) * 4096; const bf16* gwx = gwa + (size_t)DEPTH * 4 * 4096;
        bf16x8 wb[2][2][4];
#pragma unroll
        for (int e2 = 0; e2 < 2; ++e2)
#pragma unroll
            for (int ks = 0; ks < 4; ++ks) { wb[e2][0][ks] = *(const GAS bf16x8*)(gwa + (32 * e2 + r) * 64 + 16 * ks + 8 * h); wb[e2][1][ks] = *(const GAS bf16x8*)(gwx + (32 * e2 + r) * 64 + 16 * ks + 8 * h); }
        float bga[2], bgx[2], sp[2];
#pragma unroll
        for (int e2 = 0; e2 < 2; ++e2) { const int c = l * 256 + ch0 + 64 * hl + 32 * e2 + r; bga[e2] = (par + P_GAB)[c]; bgx[e2] = (par + P_GXB)[c]; sp[e2] = (par + P_SP)[c]; }
        __syncthreads();
        f32x16 accR[2], accI[2];
#pragma unroll
        for (int e2 = 0; e2 < 2; ++e2)
#pragma unroll
            for (int i = 0; i < 16; ++i) { accR[e2][i] = 0.f; accI[e2][i] = 0.f; }
#pragma unroll
        for (int ks = 0; ks < 4; ++ks) {
            const LAS float* xp = XC + (32 * tt + r) * XROW + 64 * hl + 16 * ks + 8 * h;
            const f32x4 x0 = *(const LAS f32x4*)xp, x1 = *(const LAS f32x4*)(xp + 4);
            u32x4 ap; ap.x = cvtpk2(x0.x, x0.y); ap.y = cvtpk2(x0.z, x0.w); ap.z = cvtpk2(x1.x, x1.y); ap.w = cvtpk2(x1.z, x1.w);
            const bf16x8 a = __builtin_bit_cast(bf16x8, ap);
#pragma unroll
            for (int e2 = 0; e2 < 2; ++e2) { accR[e2] = MFMA32(a, wb[e2][0][ks], accR[e2]); accI[e2] = MFMA32(a, wb[e2][1][ks], accI[e2]); }
        }
        float xcv[2][16];
#pragma unroll
        for (int e2 = 0; e2 < 2; ++e2)
#pragma unroll
            for (int i = 0; i < 16; ++i) xcv[e2][i] = XC[(32 * tt + crow(i, h)) * XROW + 64 * hl + 32 * e2 + r];
        __syncthreads();
#pragma unroll
        for (int e2 = 0; e2 < 2; ++e2)
#pragma unroll
            for (int i = 0; i < 16; ++i) { const int t = 32 * tt + crow(i, h), o = t * XROW + 64 * hl + 32 * e2 + r;
                const float rg = fsig(accR[e2][i] + bga[e2]), ig = fsig(accI[e2][i] + bgx[e2]);
                const float la = -8.0f * rg * sp[e2], a = __expf(la), x = 2.0f * la;
                const float m2 = -x * (1.0f + x * (0.5f + x * (0.16666667f + x * (0.041666668f + x * 0.008333334f))));
                float mult = __builtin_amdgcn_sqrtf(m2); if (blk == 0 && t == 0) mult = 1.0f;
                AL[o] = a; XC[o] = mult * (ig * xcv[e2][i]); }
    }
    __syncthreads();
    const int c = tid & 127, sg = tid >> 7;
    {
        float Ap = 1.f, Hs = 0.f;
#pragma unroll 8
        for (int s = 0; s < 32; ++s) { const int o = (32 * sg + s) * XROW + c; const float a = AL[o], u = XC[o]; Hs = a * Hs + u; Ap *= a; if (PASS2) { XC[o] = Hs; AL[o] = Ap; } }
        SEG[(sg * 128 + c) * 2] = Ap; SEG[(sg * 128 + c) * 2 + 1] = Hs;
    }
    __syncthreads();
    if (!PASS2) {
        if (tid < 128) { float A = 1.f, Hh = 0.f;
#pragma unroll
            for (int s = 0; s < 4; ++s) { const float As = SEG[(s * 128 + tid) * 2], Hv = SEG[(s * 128 + tid) * 2 + 1]; Hh = As * Hh + Hv; A *= As; }
            gu64* g = gran + ((size_t)((l * BATCH + b) * 64 + blk) * 256 + ch0 + tid) * 2; const unsigned long long ep = (unsigned long long)(l + 1) << 32;
            __hip_atomic_store(g, ep | __float_as_uint(A), RLX_AGENT); __hip_atomic_store(g + 1, ep | __float_as_uint(Hh), RLX_AGENT); }
        __syncthreads();
    } else {
        const LAS float* HIN = (const LAS float*)(lds + L_HIN);
        float hin = HIN[c];
        for (int s = 0; s < sg; ++s) hin = SEG[(s * 128 + c) * 2] * hin + SEG[(s * 128 + c) * 2 + 1];
#pragma unroll 8
        for (int s = 0; s < 32; ++s) { const int o = (32 * sg + s) * XROW + c; XC[o] = XC[o] + AL[o] * hin; }
        __syncthreads();
#pragma unroll
        for (int it = 0; it < 4; ++it) {
            const int idx = tid + 512 * it, t = idx >> 4, c8 = (idx & 15) * 8;
            const f32x4 h0 = *(const LAS f32x4*)(XC + t * XROW + c8), h1 = *(const LAS f32x4*)(XC + t * XROW + c8 + 4);
            const bf16x8 g = *(const GAS bf16x8*)(PROJ + (rowbase + t) * NIN + 1024 + ch0 + c8);
            u32x4 o; o.x = cvtpk2(gelu_tanh(bf2f(g[0])) * h0.x, gelu_tanh(bf2f(g[1])) * h0.y); o.y = cvtpk2(gelu_tanh(bf2f(g[2])) * h0.z, gelu_tanh(bf2f(g[3])) * h0.w);
            o.z = cvtpk2(gelu_tanh(bf2f(g[4])) * h1.x, gelu_tanh(bf2f(g[5])) * h1.y); o.w = cvtpk2(gelu_tanh(bf2f(g[6])) * h1.z, gelu_tanh(bf2f(g[7])) * h1.w);
            *(GAS u32x4*)(Y + (rowbase + t) * DM + 512 + ch0 + c8) = o;
        }
        __syncthreads();
    }
}

DI void attn(Frame& F, int l, int b, int blk, int kvh, const bf16* PROJ, bf16* Y) {
    FRESH_IDS(F);
    LAS unsigned char* lds = F.lds; const int r = lane & 31, h = lane >> 5;
    const long rowbase = (long)b * SEQ + blk * 128;
#pragma unroll
    for (int it = 0; it < 4; ++it) { const int idx = tid + 512 * it, row = idx >> 3, ch = idx & 7;
        u32x4 kv = (u32x4){0u, 0u, 0u, 0u}, vv = (u32x4){0u, 0u, 0u, 0u};
        if (blk > 0 || row >= 128) { const bf16* p = PROJ + (rowbase - 128 + row) * NIN + 512 + kvh * 64 + ch * 8; kv = *(const GAS u32x4*)p; vv = *(const GAS u32x4*)(p + 128); }
        *(LAS u32x4*)(lds + L_K + row * KROW + ch * 16) = kv; *(LAS u32x4*)(lds + L_V + row * KROW + ch * 16) = vv; }
    const int g = w >> 1, hq = 4 * kvh + g; const float slope = exp2f(-(float)(hq + 1)); const float sink = (PARF(F) + P_SINKS)[l * 8 + hq];
    bf16x8 qf[2][4];
#pragma unroll
    for (int sub = 0; sub < 2; ++sub)
#pragma unroll
        for (int ks = 0; ks < 4; ++ks) qf[sub][ks] = *(const GAS bf16x8*)(PROJ + (rowbase + 64 * (w & 1) + 32 * sub + r) * NIN + hq * 64 + 16 * ks + 8 * h);
    __syncthreads();
    LAS unsigned char* ost = lds + L_OST + w * OST_WAVE;
    const int i16 = lane & 15, q4 = i16 >> 2, p4 = i16 & 3, g1 = (lane >> 4) & 1;
#pragma unroll 1
    for (int sub = 0; sub < 2; ++sub) {
        const int r0 = 64 * (w & 1) + 32 * sub, kt0 = r0 >> 5;
        bf16x8 qs[4];
#pragma unroll
        for (int ks = 0; ks < 4; ++ks) qs[ks] = sub ? qf[1][ks] : qf[0][ks];
        f32x16 S[5];
#pragma unroll
        for (int jt = 0; jt < 5; ++jt) {
#pragma unroll
            for (int i = 0; i < 16; ++i) S[jt][i] = 0.f;
#pragma unroll
            for (int ks = 0; ks < 4; ++ks) { const bf16x8 a = *(const LAS bf16x8*)(lds + L_K + (32 * (kt0 + jt) + r) * KROW + (16 * ks + 8 * h) * 2); S[jt] = MFMA32(a, qs[ks], S[jt]); }
        }
        const int qi = r0 + r; float mx = sink;
#pragma unroll
        for (int jt = 0; jt < 5; ++jt)
#pragma unroll
            for (int i = 0; i < 16; ++i) { const int kj = 32 * (kt0 + jt) + crow(i, h), dist = qi + 128 - kj; const bool valid = (dist >= 0) && (dist < 128) && (blk > 0 || kj >= 128);
                const float s = valid ? S[jt][i] * 0.125f - slope * (float)dist : -1e30f; S[jt][i] = s; mx = fmaxf(mx, s); }
        mx = fmaxf(mx, lane_read(mx, lane ^ 32));
        float ls = 0.f; u32x4 PP[5][2];
#pragma unroll
        for (int jt = 0; jt < 5; ++jt) {
#pragma unroll
            for (int i = 0; i < 16; ++i) { const float p = __expf(S[jt][i] - mx); S[jt][i] = p; ls += p; }
#pragma unroll
            for (int s2 = 0; s2 < 2; ++s2) { PP[jt][s2].x = cvtpk2(S[jt][8 * s2 + 0], S[jt][8 * s2 + 1]); PP[jt][s2].y = cvtpk2(S[jt][8 * s2 + 2], S[jt][8 * s2 + 3]); PP[jt][s2].z = cvtpk2(S[jt][8 * s2 + 4], S[jt][8 * s2 + 5]); PP[jt][s2].w = cvtpk2(S[jt][8 * s2 + 6], S[jt][8 * s2 + 7]); }
        }
        ls += lane_read(ls, lane ^ 32);
        const float inv = 1.0f / (ls + __expf(sink - mx));
        f32x16 O0, O1;
#pragma unroll
        for (int i = 0; i < 16; ++i) { O0[i] = 0.f; O1[i] = 0.f; }
        const LAS unsigned char* vbase = lds + L_V + (32 * kt0 + 4 * h + q4) * KROW + (16 * g1 + 4 * p4) * 2;
#pragma unroll
        for (int jt = 0; jt < 5; ++jt)
#pragma unroll
            for (int s2 = 0; s2 < 2; ++s2) {
                const bf16x8 pa = __builtin_bit_cast(bf16x8, PP[jt][s2]);
                const LAS unsigned char* vp = vbase + (32 * jt + 16 * s2) * KROW;
                const v4i16_t lo0 = __builtin_amdgcn_ds_read_tr16_b64_v4i16((LAS v4i16_t*)(vp)), hi0 = __builtin_amdgcn_ds_read_tr16_b64_v4i16((LAS v4i16_t*)(vp + 8 * KROW));
                const v4i16_t lo1 = __builtin_amdgcn_ds_read_tr16_b64_v4i16((LAS v4i16_t*)(vp + 64)), hi1 = __builtin_amdgcn_ds_read_tr16_b64_v4i16((LAS v4i16_t*)(vp + 8 * KROW + 64));
                const bf16x8 v0 = (bf16x8){lo0[0], lo0[1], lo0[2], lo0[3], hi0[0], hi0[1], hi0[2], hi0[3]}, v1 = (bf16x8){lo1[0], lo1[1], lo1[2], lo1[3], hi1[0], hi1[1], hi1[2], hi1[3]};
                O0 = MFMA32(pa, v0, O0); O1 = MFMA32(pa, v1, O1);
            }
#pragma unroll
        for (int i = 0; i < 16; ++i) { const int qrow = crow(i, h); const float iq = lane_read(inv, qrow);
            *(LAS unsigned short*)(ost + qrow * KROW + r * 2) = (unsigned short)f2bf(O0[i] * iq); *(LAS unsigned short*)(ost + qrow * KROW + (32 + r) * 2) = (unsigned short)f2bf(O1[i] * iq); }
        asm volatile("s_waitcnt lgkmcnt(0)" ::: "memory");
#pragma unroll
        for (int it = 0; it < 4; ++it) { const int row = it * 8 + (lane >> 3), ch = lane & 7; const u32x4 v = *(const LAS u32x4*)(ost + row * KROW + ch * 16);
            *(GAS u32x4*)(Y + (rowbase + r0 + row) * DM + hq * 64 + ch * 8) = v; }
        asm volatile("s_waitcnt lgkmcnt(0)" ::: "memory");
    }
    __syncthreads();
}

DI void sconv(Frame& F, int l, int b, int blk, int kvh, const bf16* PROJ, bf16* Y) {
    FRESH_IDS(F);
    const long rowbase = (long)b * SEQ + blk * 128;
    const float* scw = PARF(F) + P_SCW + l * 3 * 256;
#pragma unroll
    for (int it = 0; it < 4; ++it) {
        const int idx = tid + 512 * it, t = idx >> 4, c = 128 * kvh + (idx & 15) * 8;
        float acc[8];
#pragma unroll
        for (int i = 0; i < 8; ++i) acc[i] = 0.f;
#pragma unroll
        for (int k = 0; k < 3; ++k) { const int tt = t - 2 + k;
            if (blk > 0 || tt >= 0) {
                const bf16* p = PROJ + (rowbase + tt) * NIN + c;
                const bf16x8 sc = *(const GAS bf16x8*)(p + 1536), sx = *(const GAS bf16x8*)(p + 1792);
                const f32x4 w0 = *(const GAS f32x4*)(scw + k * 256 + c), w1 = *(const GAS f32x4*)(scw + k * 256 + c + 4);
                acc[0] += w0.x * (bf2f(sc[0]) * bf2f(sx[0])); acc[1] += w0.y * (bf2f(sc[1]) * bf2f(sx[1])); acc[2] += w0.z * (bf2f(sc[2]) * bf2f(sx[2])); acc[3] += w0.w * (bf2f(sc[3]) * bf2f(sx[3]));
                acc[4] += w1.x * (bf2f(sc[4]) * bf2f(sx[4])); acc[5] += w1.y * (bf2f(sc[5]) * bf2f(sx[5])); acc[6] += w1.z * (bf2f(sc[6]) * bf2f(sx[6])); acc[7] += w1.w * (bf2f(sc[7]) * bf2f(sx[7])); } }
        const bf16x8 sb = *(const GAS bf16x8*)(PROJ + (rowbase + t) * NIN + 1280 + c);
        u32x4 o; o.x = cvtpk2(bf2f(sb[0]) * acc[0], bf2f(sb[1]) * acc[1]); o.y = cvtpk2(bf2f(sb[2]) * acc[2], bf2f(sb[3]) * acc[3]);
        o.z = cvtpk2(bf2f(sb[4]) * acc[4], bf2f(sb[5]) * acc[5]); o.w = cvtpk2(bf2f(sb[6]) * acc[6], bf2f(sb[7]) * acc[7]);
        *(GAS u32x4*)(Y + (rowbase + t) * DM + 768 + c) = o;
    }
}

DI void gather_carry(Frame& F, int l, int b, int blk, int kvh, gu64* gran) {
    FRESH_IDS(F);
    LAS float* HIN = (LAS float*)(F.lds + L_HIN); LAS float* GP = (LAS float*)(F.lds + L_GP);
    const int c = tid & 127, part = tid >> 7, per = (blk + 3) >> 2, jlo = part * per, jhi = (jlo + per < blk) ? jlo + per : blk;
    float Ac = 1.f, Hc = 0.f;
    gu64* gp = gran + ((size_t)((l * BATCH + b) * 64) * 256 + 128 * kvh + c) * 2;
    const unsigned ep = (unsigned)(l + 1);
    for (int j0 = jlo; j0 < jhi; j0 += 8) {
        unsigned long long ga[8], gh[8]; unsigned spins = 0u;
        for (;;) { bool ok = true;
#pragma unroll
            for (int k = 0; k < 8; ++k) if (j0 + k < jhi) { ga[k] = __hip_atomic_load(gp + (size_t)(j0 + k) * 512, RLX_AGENT); gh[k] = __hip_atomic_load(gp + (size_t)(j0 + k) * 512 + 1, RLX_AGENT);
                ok = ok && ((unsigned)(ga[k] >> 32) == ep) && ((unsigned)(gh[k] >> 32) == ep); }
            if (__all(ok)) break;
            if (++spins > (1u << 16)) { if (lane == 0) set_tmo(F, 0x500u | (unsigned)blk); break; }
            __builtin_amdgcn_s_sleep(4);
        }
#pragma unroll
        for (int k = 0; k < 8; ++k) if (j0 + k < jhi) { const float a = __uint_as_float((unsigned)ga[k]), hh = __uint_as_float((unsigned)gh[k]); Hc = a * Hc + hh; Ac *= a; }
    }
    GP[(part * 128 + c) * 2] = Ac; GP[(part * 128 + c) * 2 + 1] = Hc;
    __syncthreads();
    if (tid < 128) { float hc = 0.f;
#pragma unroll
        for (int p = 0; p < 4; ++p) hc = GP[(p * 128 + tid) * 2] * hc + GP[(p * 128 + tid) * 2 + 1];
        HIN[tid] = hc; }
    __syncthreads();
}

DI void mix_phase(Frame& F, int l) {
    const bf16* PROJ = (const bf16*)(F.ws + WS_PROJ); bf16* Y = (bf16*)(F.ws + WS_Y); gu64* gran = (gu64*)(F.ws + WS_GRAN);
    for (int u = F.vcu; u < 256; u += F.G) {
        const int b = u >> 7, blk = (u >> 1) & 63, kvh = u & 1;
#ifndef MIX_REP
#define MIX_REP 0
#endif
        for (int q_ = 0; q_ < ((MIX_REP & 1) ? 2 : 1); ++q_) lru_unit<false>(F, l, b, blk, kvh, PROJ, Y, gran);
        for (int q_ = 0; q_ < ((MIX_REP & 2) ? 2 : 1); ++q_) attn(F, l, b, blk, kvh, PROJ, Y);
        for (int q_ = 0; q_ < ((MIX_REP & 4) ? 2 : 1); ++q_) sconv(F, l, b, blk, kvh, PROJ, Y);
        for (int q_ = 0; q_ < ((MIX_REP & 8) ? 2 : 1); ++q_) { gather_carry(F, l, b, blk, kvh, gran); lru_unit<true>(F, l, b, blk, kvh, PROJ, Y, gran); }
    }
}
}

__global__ void __launch_bounds__(NWAVES * 64, 2) trunk_fwd(Args args) {
    extern __shared__ __attribute__((aligned(16))) unsigned char lds[];
    Frame F;
    F.lds = (LAS unsigned char*)lds;
    F.MISC = (volatile LAS unsigned*)(F.lds + MISC_OFF);
    F.G = gridDim.x; F.bx = blockIdx.x; { const int bx = blockIdx.x; F.vcu = (F.G % 8 == 0) ? (bx % 8) * (F.G / 8) + bx / 8 : bx; }
    F.ws = args.ws; F.out = args.out; F.xin = args.in[IN_X]; F.ctl = (gu32*)(args.ws + WS_CTL);
    for (int u = threadIdx.x; u < (LDS_BYTES - LDSCTL_OFF) / 4; u += NWAVES * 64) ((LAS unsigned*)(F.lds + LDSCTL_OFF))[u] = 0u;
    __syncthreads();
    XcdBarrier bar; bar.bar = (unsigned*)(F.ctl + CW_BAR); bar.x = 0; bar.st = nullptr;
    if (!MK_PER_PHASE) bar = xcd_barrier_post((unsigned*)(F.ctl + CW_BAR), F.MISC + 8);

    const int lo = args.ph_lo, hi = args.ph_hi;
    if (lo == 0) { if (EN_P0) p0_phase(F, args); if (REP_MASK & 1) { { XcdBarrier bb = bar; asm volatile("" : "+s"(bb.bar)); xcd_barrier(bb); } p0_phase(F, args); } if (1 < hi) { XcdBarrier bb = bar; asm volatile("" : "+s"(bb.bar)); xcd_barrier(bb); } }
    for (int ph = (lo > 1 ? lo : 1); ph < hi; ++ph) {
        { int bx_ = blockIdx.x; unsigned char* ws_ = args.ws; float* out_ = args.out; asm volatile("" : "+s"(bx_), "+s"(ws_), "+s"(out_));
          F.ws = ws_; F.out = out_; F.bx = bx_; F.vcu = (F.G % 8 == 0) ? (bx_ % 8) * (F.G / 8) + bx_ / 8 : bx_; }
        int nrep = 1;
        if (REP_MASK) { const int k_ = (ph - 2) % 10; const bool isnorm = (ph == 1) || k_ == 2 || k_ == 6 || (k_ == 9 && ph != NPHASE - 1);
            if (((REP_MASK & 2) && isnorm) || ((REP_MASK & 4) && ph > 1 && (k_ == 0 || k_ == 7)) || ((REP_MASK & 8) && ph > 1 && (k_ == 1 || k_ == 8 || k_ == 5)) || ((REP_MASK & 16) && ph > 1 && k_ == 3) || ((REP_MASK & 32) && ph > 1 && k_ == 4)) nrep = 2; }
        for (int rep = 0; rep < nrep; ++rep) {
        if (rep) { XcdBarrier bb = bar; asm volatile("" : "+s"(bb.bar)); xcd_barrier(bb); }
        const float rcoef = rep ? 0.0f : 1.0f;
        if (ph == 1) norm_phase(F, F.xin, 0, 0);
        else {
            const int l = (ph - 2) / 10, k = (ph - 2) % 10;
            const float* mod = (const float*)(F.ws + WS_MOD);
            if ((k == 0 || k == 7) && EN_G1) {
                const int f = (k == 7);
                pg8::Gemm g{(const pg8::bf16_t*)(F.ws + WS_H), (const pg8::bf16_t*)(F.ws + WS_WGU) + (size_t)(l * 2 + f) * NGU * DM, M, NGU, DM};
                pg8::StaticOrder S; S.init(M, NGU, F.G, F.bx);
                pg8::EpiSwiglu E{(pg8::bf16_t*)(F.ws + WS_ACT), DFF};
                pg8::gemm_phase<pg8::EpiSwiglu, pg8::StaticOrder, true, PG8_SP2>(F.lds + RING_OFF, g, S, E);
            } else if ((k == 1 || k == 8) && EN_G2) {
                pg8::Gemm g{(const pg8::bf16_t*)(F.ws + WS_ACT), (const pg8::bf16_t*)(F.ws + WS_WDN) + (size_t)(l * 2 + (k == 8)) * DM * DFF, M, DM, DFF};
                pg8::StaticOrder S; S.init(M, DM, F.G, F.bx);
                pg8::EpiResid E{(l == 0 && k == 1 && rep == 0) ? F.xin : (const float*)F.out, F.out, mod + (size_t)(l * BATCH) * NMODV + (k == 1 ? 2 : 8) * DM, NMODV, 0.5f * rcoef};
                pg8::gemm_phase<pg8::EpiResid, pg8::StaticOrder, true, PG8_SP2>(F.lds + RING_OFF, g, S, E);
            } else if (k == 5 && EN_G2) {
                pg8::Gemm g{(const pg8::bf16_t*)(F.ws + WS_Y), (const pg8::bf16_t*)(F.ws + WS_WOUT) + (size_t)l * DM * DM, M, DM, DM};
                pg8::StaticOrder S; S.init(M, DM, F.G, F.bx);
                pg8::EpiResid E{(const float*)F.out, F.out, mod + (size_t)(l * BATCH) * NMODV + 5 * DM, NMODV, rcoef};
                pg8::gemm_phase<pg8::EpiResid, pg8::StaticOrder, true, PG8_SP2>(F.lds + RING_OFF, g, S, E);
            } else if (k == 3 && EN_G3) {
                pg8::Gemm g{(const pg8::bf16_t*)(F.ws + WS_H), (const pg8::bf16_t*)(F.ws + WS_WIN) + (size_t)l * NIN * DM, M, NIN, DM};
                pg8::StaticOrder S; S.init(M, NIN, F.G, F.bx);
                pg8::EpiBf16Plain E{(pg8::bf16_t*)(F.ws + WS_PROJ), NIN};
                pg8::gemm_phase<pg8::EpiBf16Plain, pg8::StaticOrder, true, PG8_SP2>(F.lds + RING_OFF, g, S, E);
            } else if (k == 4 && EN_MIX) {
                mixp::mix_phase(F, l);
            } else if (k == 2) norm_phase(F, F.out, l, 1);
            else if (k == 6) norm_phase(F, F.out, l, 2);
            else if (k == 9) {
                if (l + 1 < DEPTH) norm_phase(F, F.out, l + 1, 0);
                else { bool poison = __hip_atomic_load(F.ctl + CW_TMO, RLX_AGENT) != 0u;
                    if (!MK_PER_PHASE) poison |= __hip_atomic_load((gu32*)((const unsigned*)(F.ctl + CW_BAR) + XB_TMO), RLX_AGENT) != 0u;
                    final_phase(F, poison); }
            }
        }
        }
        if (ph + 1 < hi) { XcdBarrier bb = bar; asm volatile("" : "+s"(bb.bar)); xcd_barrier(bb); if (REP_MASK & 64) { XcdBarrier bc = bar; asm volatile("" : "+s"(bc.bar)); xcd_barrier(bc); } }
    }
}

extern "C" void kernel_launch(void* const* d_in, const int* in_sizes, int n_in, void* d_out, int out_size, void* d_ws, size_t ws_size, hipStream_t stream) {
    static int grid = 0;
    if (grid == 0) {
        if (n_in != N_IN || in_sizes[0] != M * DM || out_size != M * DM || ws_size < WS_END) { fprintf(stderr, "kernel_launch: unexpected shapes: n_in %d in0 %d out %d ws %zu; nothing launched\n", n_in, n_in > 0 ? in_sizes[0] : -1, out_size, ws_size); grid = -1; return; }
        int dev = 0, cus = 0, per_cu = 0;
        if (hipGetDevice(&dev) != hipSuccess || hipDeviceGetAttribute(&cus, hipDeviceAttributeMultiprocessorCount, dev) != hipSuccess) { fprintf(stderr, "kernel_launch: device query failed\n"); grid = -1; return; }
        if (hipFuncSetAttribute((const void*)trunk_fwd, hipFuncAttributeMaxDynamicSharedMemorySize, LDS_BYTES) != hipSuccess) { fprintf(stderr, "kernel_launch: hipFuncSetAttribute failed\n"); grid = -1; return; }
        if (hipOccupancyMaxActiveBlocksPerMultiprocessor(&per_cu, (const void*)trunk_fwd, NWAVES * 64, LDS_BYTES) != hipSuccess || per_cu < 1) { fprintf(stderr, "kernel_launch: occupancy query reports %d workgroups per CU\n", per_cu); (void)hipGetLastError(); grid = -1; return; }
        grid = cus;
    }
    if (grid < 0) return;
    if (hipMemsetAsync((char*)d_ws + WS_CTL, 0, CTL_ZERO_BYTES, stream) != hipSuccess) { fprintf(stderr, "kernel_launch: memset failed\n"); return; }
    Args a{};
    for (int i = 0; i < N_IN; ++i) a.in[i] = (const float*)d_in[i];
    a.out = (float*)d_out; a.ws = (unsigned char*)d_ws;
#if MK_PER_PHASE
    for (int p = 0; p < NPHASE; ++p) { a.ph_lo = p; a.ph_hi = p + 1; a.li = p; hipLaunchKernelGGL(trunk_fwd, dim3(grid), dim3(NWAVES * 64), LDS_BYTES, stream, a); }
#else
    a.ph_lo = 0; a.ph_hi = NPHASE; a.li = 0;
    hipLaunchKernelGGL(trunk_fwd, dim3(grid), dim3(NWAVES * 64), LDS_BYTES, stream, a);
#endif
    const hipError_t le = hipPeekAtLastError();
    if (le != hipSuccess) fprintf(stderr, "kernel_launch: launch failed: %s\n", hipGetErrorName(le));
}
```
